# Optimizing an MI355X kernel written in HIP

```python
import math
import jax, jax.numpy as jnp
from jax import lax
import numpy as np

D_MODEL = 1024
BATCH = 8
SEQ = 4096
DEPTH = 1

GRID_W = 64
CONV_W = 512
CONV_K = 3
N_HEADS = 8
HEAD_DIM = 64
ATTN_W = N_HEADS * HEAD_DIM
WIN_R = 8
WIN_C = 16
Q_ROWS = 8
Q_COLS = 16
K_COLS = 32
N_CBLK = GRID_W // Q_COLS
NEG_INF = -1e30
N_BRANCH = 2
PROJ_W = 3 * CONV_W + 3 * ATTN_W + N_BRANCH * D_MODEL
N_EXPERTS = 32
TOP_K = 4
D_EXPERT = D_MODEL
SWIGLU_ALPHA = 1.702
SWIGLU_LIMIT = 7.0
MOE_BLOCK = 128
NORM_EPS = 1e-6

kernel_name = "hybrid_shortconv_natten_moe_block"


def rms_norm(x, g):
    xf = x.astype(jnp.float32)
    y = xf * lax.rsqrt(jnp.mean(xf * xf, axis=-1, keepdims=True) + NORM_EPS)
    return (y * g.astype(jnp.float32)).astype(x.dtype)


def short_conv_mixer(x_in, b_gate, c_gate, conv_w):
    u = c_gate * x_in
    up = jnp.pad(u, ((0, 0), (1, 1), (0, 0)))
    conv = conv_w[0] * up[:, :-2] + conv_w[1] * up[:, 1:-1] + conv_w[2] * up[:, 2:]
    return b_gate * conv


def grid_layout(rows):
    wr = min(WIN_R, rows)
    qr = math.gcd(rows, Q_ROWS)
    kr = min(rows, qr + wr)
    n_rb = rows // qr
    rs = np.clip(np.arange(rows) - wr // 2, 0, rows - wr)
    cs = np.clip(np.arange(GRID_W) - WIN_C // 2, 0, GRID_W - WIN_C)
    q_rows = np.arange(rows).reshape(n_rb, qr)
    q_cols = np.arange(GRID_W).reshape(N_CBLK, Q_COLS)
    key_rows = np.clip(q_rows[:, 0] - wr // 2, 0, rows - kr)[:, None] + np.arange(kr)
    key_cols = np.clip(q_cols[:, 0] - WIN_C // 2, 0, GRID_W - K_COLS)[:, None] + np.arange(K_COLS)
    kr_b = key_rows[:, None, None, None, :, None]
    qr_b = q_rows[:, None, :, None, None, None]
    kc_b = key_cols[None, :, None, None, None, :]
    qc_b = q_cols[None, :, None, :, None, None]
    valid = ((kr_b >= rs[qr_b]) & (kr_b < rs[qr_b] + wr)
             & (kc_b >= cs[qc_b]) & (kc_b < cs[qc_b] + WIN_C))
    ridx = np.clip(kr_b - qr_b + WIN_R - 1, 0, 2 * WIN_R - 2)
    cidx = np.clip(kc_b - qc_b + WIN_C - 1, 0, 2 * WIN_C - 2)
    return qr, key_rows, key_cols, valid, ridx, cidx


def neighbourhood_attention(q, k, v, rpb):
    b, s, h, hd = q.shape
    rows = s // GRID_W
    qr, key_rows, key_cols, valid, ridx, cidx = grid_layout(rows)
    n_rb = rows // qr
    qg = q.reshape(b, n_rb, qr, N_CBLK, Q_COLS, h, hd)
    ridx_g = key_rows[:, :, None, None]
    cidx_g = key_cols[None, None, :, :]
    kg = k.reshape(b, rows, GRID_W, h, hd)[:, ridx_g, cidx_g]
    vg = v.reshape(b, rows, GRID_W, h, hd)[:, ridx_g, cidx_g]
    bias = jnp.where(jnp.asarray(valid), rpb[:, ridx, cidx].astype(jnp.float32), NEG_INF)
    scores = jnp.einsum('biajchd,bikjlhd->bhijackl', qg, kg,
                        preferred_element_type=jnp.float32) * (HEAD_DIM ** -0.5) + bias[None]
    probs = jax.nn.softmax(scores.reshape(*scores.shape[:-2], -1), axis=-1).reshape(scores.shape)
    out = jnp.einsum('bhijackl,bikjlhd->biajchd', probs.astype(v.dtype), vg)
    return out.reshape(b, s, h * hd)


def moe_ffn(h, w_router, b_router, w_gate, b_gate, w_up, b_up, w_down, b_down):
    b, s, d = h.shape
    n_tok = b * s
    n_asg = n_tok * TOP_K
    xt = h.reshape(n_tok, d)
    logits = jnp.dot(xt, w_router, preferred_element_type=jnp.float32) + b_router.astype(jnp.float32)
    top_v, top_i = lax.top_k(logits, TOP_K)
    gates = jax.nn.softmax(top_v, axis=-1)
    e_flat = top_i.reshape(n_asg).astype(jnp.int32)
    tok_flat = jnp.arange(n_asg, dtype=jnp.int32) // TOP_K
    order = jnp.argsort(e_flat)
    e_sorted = e_flat[order]
    tok_sorted = tok_flat[order]
    g_sorted = gates.reshape(n_asg)[order]
    counts = jnp.zeros((N_EXPERTS,), jnp.int32).at[e_flat].add(1)
    group_start = jnp.cumsum(counts) - counts
    padded = (counts + MOE_BLOCK - 1) // MOE_BLOCK * MOE_BLOCK
    padded_end = jnp.cumsum(padded)
    padded_start = padded_end - padded
    dest = padded_start[e_sorted] + jnp.arange(n_asg, dtype=jnp.int32) - group_start[e_sorted]
    n_blocks = -(-n_asg // MOE_BLOCK) + N_EXPERTS
    n_rows = n_blocks * MOE_BLOCK
    row_token = jnp.zeros((n_rows,), jnp.int32).at[dest].set(tok_sorted)
    row_gate = jnp.zeros((n_rows,), jnp.float32).at[dest].set(g_sorted)
    block_expert = jnp.minimum(
        jnp.searchsorted(padded_end, jnp.arange(n_blocks, dtype=jnp.int32) * MOE_BLOCK, side='right'),
        N_EXPERTS - 1).astype(jnp.int32)

    def expert_block(args):
        idx, gate, e = args
        xb = xt[idx]
        g = jnp.minimum(xb @ w_gate[e] + b_gate[e], SWIGLU_LIMIT)
        u = jnp.clip(xb @ w_up[e] + b_up[e], -SWIGLU_LIMIT, SWIGLU_LIMIT)
        act = g * jax.nn.sigmoid(SWIGLU_ALPHA * g) * (u + 1)
        y = act @ w_down[e] + b_down[e]
        return y * gate[:, None].astype(y.dtype)

    y_rows = lax.map(expert_block, (row_token.reshape(n_blocks, MOE_BLOCK),
                                    row_gate.reshape(n_blocks, MOE_BLOCK),
                                    block_expert)).reshape(n_rows, d)
    y = jax.ops.segment_sum(y_rows, row_token, num_segments=n_tok)
    return y.reshape(b, s, d).astype(h.dtype)


def setup_inputs(seed: int = 0) -> dict:
    key = jax.random.key(seed)
    ks = jax.random.split(key, 20)
    f32 = jnp.float32
    nrm = lambda k, shape, scale: jax.random.normal(k, shape, f32) * scale
    L, D, E, F = DEPTH, D_MODEL, N_EXPERTS, D_EXPERT
    return {
        'x': nrm(ks[0], (BATCH, SEQ, D), 1.0),
        'norm_mix': 1.0 + nrm(ks[1], (L, D), 0.01),
        'w_in': nrm(ks[2], (L, D, PROJ_W), D ** -0.5),
        'conv_w': nrm(ks[3], (L, CONV_K, CONV_W), CONV_K ** -0.5),
        'w_out_conv': nrm(ks[4], (L, CONV_W, D), CONV_W ** -0.5),
        'q_norm': 1.0 + nrm(ks[5], (L, HEAD_DIM), 0.01),
        'k_norm': 1.0 + nrm(ks[6], (L, HEAD_DIM), 0.01),
        'rpb': nrm(ks[7], (L, N_HEADS, 2 * WIN_R - 1, 2 * WIN_C - 1), 0.02),
        'w_out_attn': nrm(ks[8], (L, ATTN_W, D), ATTN_W ** -0.5),
        'w_o': nrm(ks[9], (L, D, D), D ** -0.5),
        'norm_ffn': 1.0 + nrm(ks[10], (L, D), 0.01),
        'w_router': nrm(ks[11], (L, D, E), D ** -0.5),
        'b_router': nrm(ks[12], (L, E), 0.01),
        'w_gate': nrm(ks[13], (L, E, D, F), D ** -0.5),
        'b_gate': nrm(ks[14], (L, E, F), 0.01),
        'w_up': nrm(ks[15], (L, E, D, F), D ** -0.5),
        'b_up': nrm(ks[16], (L, E, F), 0.01),
        'w_down': nrm(ks[17], (L, E, F, D), F ** -0.5),
        'b_down': nrm(ks[18], (L, E, D), 0.01),
    }


def reference(x, norm_mix, w_in, conv_w, w_out_conv, q_norm, k_norm, rpb, w_out_attn, w_o,
              norm_ffn, w_router, b_router, w_gate, b_gate, w_up, b_up, w_down, b_down):
    b, s, d = x.shape
    split_points = [CONV_W, 2 * CONV_W, 3 * CONV_W,
                    3 * CONV_W + ATTN_W, 3 * CONV_W + 2 * ATTN_W, 3 * CONV_W + 3 * ATTN_W,
                    3 * CONV_W + 3 * ATTN_W + D_MODEL]
    for l in range(DEPTH):
        h = rms_norm(x, norm_mix[l])
        proj = h @ w_in[l]
        x_in, b_g, c_g, q, k, v, gate_a, gate_b = jnp.split(proj, split_points, axis=-1)
        y_conv = short_conv_mixer(x_in, b_g, c_g, conv_w[l]) @ w_out_conv[l]
        q = rms_norm(q.reshape(b, s, N_HEADS, HEAD_DIM), q_norm[l])
        k = rms_norm(k.reshape(b, s, N_HEADS, HEAD_DIM), k_norm[l])
        v = v.reshape(b, s, N_HEADS, HEAD_DIM)
        y_attn = neighbourhood_attention(q, k, v, rpb[l]) @ w_out_attn[l]
        mixed = jax.nn.sigmoid(gate_a) * y_conv + jax.nn.sigmoid(gate_b) * y_attn
        x = x + mixed @ w_o[l]
        h = rms_norm(x, norm_ffn[l])
        x = x + moe_ffn(h, w_router[l], b_router[l], w_gate[l], b_gate[l],
                        w_up[l], b_up[l], w_down[l], b_down[l])
    return x
```

```cpp
#include <hip/hip_runtime.h>
#include <cstdio>
#include <cstdint>

#ifndef MK_MULTI
#define MK_MULTI 0
#endif

#ifndef PROBE_REP
#define PROBE_REP 0
#endif
#define LAS __attribute__((address_space(3)))
#define GAS __attribute__((address_space(1)))
typedef unsigned short bf16_t;
typedef short bf16x8 __attribute__((ext_vector_type(8)));
typedef short s16x4 __attribute__((ext_vector_type(4)));
typedef float f32x4 __attribute__((ext_vector_type(4)));
typedef float f32x2 __attribute__((ext_vector_type(2)));
typedef unsigned u32x4 __attribute__((ext_vector_type(4)));
typedef unsigned u32x2 __attribute__((ext_vector_type(2)));

constexpr int D = 1024, NB = 8, SEQ = 4096, M = NB * SEQ;
constexpr int CONVW = 512, NH = 8, HD = 64, ATTW = 512, PROJW = 5120;
constexpr int NE = 32, TOPK = 4, FF = 1024, NASG = M * TOPK, CAP = M;
constexpr float NORM_EPS = 1e-6f, LOG2E = 1.4426950408889634f;
constexpr int NTHREADS = 512, NWAVES = 8;

constexpr size_t MiB = 1u << 20;
constexpr size_t WS_CTL = 0, CTL_ZERO_BYTES = 64 * 1024;
constexpr size_t WS_WRH = 1 * MiB, WS_WRL = 1 * MiB + 65536;
constexpr size_t WS_ROWTOK = 2 * MiB;
constexpr size_t WS_TOKPOS = 6 * MiB, WS_TOKGATE = 6 * MiB + 512 * 1024;
constexpr size_t WS_RSTD2 = 7 * MiB;
constexpr size_t WS_WIN = 8 * MiB, WS_WCA = 18 * MiB, WS_WO = 20 * MiB;
constexpr size_t WS_WD = 24 * MiB, WS_WGU = 56 * MiB;
constexpr size_t WS_XB = 120 * MiB;
constexpr size_t WS_ACT = 152 * MiB;
constexpr size_t WS_Y = 281 * MiB;
constexpr size_t WS_X1 = 409 * MiB;
constexpr size_t WS_END = WS_X1 + (size_t)M * D * 2;
static_assert(WS_ACT + (size_t)(NASG + 256) * FF <= WS_Y && WS_Y + (size_t)NASG * D <= WS_X1, "ws map");
constexpr size_t WS_U = 152 * MiB, WS_BG = 184 * MiB, WS_Q = 216 * MiB, WS_K = 248 * MiB, WS_V = 280 * MiB, WS_R = 312 * MiB, WS_SB = 376 * MiB;
constexpr size_t WS_MIXED = 152 * MiB;
constexpr float WSCALE = 64.0f, WINV = 1.0f / 64.0f;
constexpr int CW_TMO = 0, CW_CNT = 64  , CW_BAR = 4096;

constexpr int RING_BYTES = 131072;
constexpr int LDS_X = 132096;
constexpr int LDS_TAB = 148992;
constexpr int LDS_CNT = 149504;
constexpr int LDS_MISC = 149760;
constexpr int LDS_BYTES = 163840;
static_assert(LDS_MISC + 256 <= LDS_BYTES, "lds map");

#define RLX_AGENT __ATOMIC_RELAXED, __HIP_MEMORY_SCOPE_AGENT
#define LDS_WAIT() asm volatile("s_waitcnt lgkmcnt(0)" ::: "memory")
#define VM_WAIT() asm volatile("s_waitcnt vmcnt(0)" ::: "memory")
__device__ __forceinline__ unsigned cvt_pk_bf16(float lo, float hi) { unsigned r; asm volatile("v_cvt_pk_bf16_f32 %0, %1, %2" : "=v"(r) : "v"(lo), "v"(hi)); return r; }
__device__ __forceinline__ float bf_lo(unsigned w) { return __uint_as_float(w << 16); }
__device__ __forceinline__ float bf_hi(unsigned w) { return __uint_as_float(w & 0xffff0000u); }
__device__ __forceinline__ int clampi(int v, int lo, int hi) { return v < lo ? lo : (v > hi ? hi : v); }

#define XB_TMO      128
#define XB_XCNT(j)  (256  + 64 * (j))
#define XB_XSUB(j)  (1280 + 64 * (j))
#define XB_XGEN(j)  (2304 + 64 * (j))
#define XB_TOP      3328
#define XB_TOPGEN   3392
#define XCD_BAR_WORDS 3456
#define XB_SPIN_CAP (1u << 18)
__device__ __forceinline__ unsigned xb_ld(unsigned* p)              { return __hip_atomic_load(p, __ATOMIC_RELAXED, __HIP_MEMORY_SCOPE_AGENT); }
__device__ __forceinline__ unsigned xb_add(unsigned* p, unsigned v) { return __hip_atomic_fetch_add(p, v, __ATOMIC_RELAXED, __HIP_MEMORY_SCOPE_AGENT); }
__device__ __forceinline__ unsigned xb_xcc_id() { return (unsigned)__builtin_amdgcn_s_getreg((3 << 11) | 20) & 0xFu; }
#define XB_SPIN(cond, bar) do { unsigned _sp = 0; while (cond) { __builtin_amdgcn_s_sleep(1); \
    if ((++_sp & 255u) == 0u) { if (xb_ld(&(bar)[XB_TMO])) break; if (_sp > XB_SPIN_CAP) { atomicAdd(&(bar)[XB_TMO], 1u); break; } } } } while (0)
struct XcdBarrier { unsigned* bar; unsigned x; volatile LAS unsigned* st; };
__device__ __forceinline__ XcdBarrier xcd_barrier_post(unsigned* bar, volatile LAS unsigned* st) {
    XcdBarrier b; b.bar = bar; b.x = xb_xcc_id(); b.st = st;
    if (threadIdx.x == 0) (void)xb_add(&bar[XB_XCNT(b.x)], 1u);
    return b;
}
__device__ __forceinline__ void xcd_barrier_complete(unsigned* bar, unsigned x, unsigned& nloc, unsigned& nx) {
    const unsigned G = gridDim.x * gridDim.y * gridDim.z;
    unsigned sum, cnt, mine, sp = 0u;
    for (;;) {
        sum = 0u; cnt = 0u; mine = 0u;
#pragma unroll
        for (unsigned j = 0; j < 16; ++j) { const unsigned c = xb_ld(&bar[XB_XCNT(j)]); sum += c; cnt += (c > 0u) ? 1u : 0u; mine = (j == x) ? c : mine; }
        if (sum == G) break;
        __builtin_amdgcn_s_sleep(1);
        if ((++sp & 255u) == 0u) { if (xb_ld(&bar[XB_TMO])) break; if (sp > XB_SPIN_CAP) { atomicAdd(&bar[XB_TMO], 1u); break; } }
    }
    nloc = mine > 0u ? mine : 1u; nx = cnt > 0u ? cnt : 1u;
}
__device__ __forceinline__ void xcd_barrier(const XcdBarrier& b) {
    asm volatile("s_waitcnt vmcnt(0)" ::: "memory");
    __syncthreads();
    if (threadIdx.x == 0) {
        unsigned* bar = b.bar;
        __builtin_amdgcn_s_waitcnt(0);
        unsigned nloc = b.st[0], nx = b.st[1];
        if (nloc == 0u) { xcd_barrier_complete(bar, b.x, nloc, nx); b.st[0] = nloc; b.st[1] = nx; }
        const unsigned old = xb_add(&bar[XB_XSUB(b.x)], 1u);
        const unsigned gen = old / nloc;
        if (old + 1u == (gen + 1u) * nloc) {
            __builtin_amdgcn_fence(__ATOMIC_RELEASE, "agent");
            asm volatile("s_waitcnt vmcnt(0)" ::: "memory");
            const unsigned og = xb_add(&bar[XB_TOP], 1u);
            const unsigned tg = og / nx;
            if (og + 1u == (tg + 1u) * nx) xb_add(&bar[XB_TOPGEN], 1u);
            else XB_SPIN(xb_ld(&bar[XB_TOPGEN]) == tg, bar);
            __builtin_amdgcn_fence(__ATOMIC_ACQUIRE, "agent");
            xb_add(&bar[XB_XGEN(b.x)], 1u);
            asm volatile("s_waitcnt vmcnt(0)" ::: "memory");
        } else {
            XB_SPIN(xb_ld(&bar[XB_XGEN(b.x)]) == gen, bar);
            __builtin_amdgcn_fence(__ATOMIC_ACQUIRE, "agent");
            asm volatile("s_waitcnt vmcnt(0)" ::: "memory");
        }
    }
    __syncthreads();
}

namespace pg8 {
constexpr int BM = 256, BK = 64, HALF = 128, HTB = HALF * BK * 2, NXCD = 8, WGM = 8;
__host__ __device__ __forceinline__ int lds_byte(int r, int c) { const int st = (r >> 4) * 2 + (c >> 5), rr = r & 15, cc = c & 31, ob = rr * 64 + cc * 2; return st * 1024 + (ob ^ (((ob >> 9) & 1) << 5)); }
__host__ __device__ __forceinline__ void stage_rc(int b, int& R, int& C) { const int st = b / 1024, sb = b % 1024, swz = sb ^ (((sb >> 9) & 1) << 5); R = (st >> 1) * 16 + swz / 64; C = (st & 1) * 32 + (swz % 64) / 2; }
__host__ __device__ __forceinline__ int perm32(int rho) { const int n = rho >> 4, i = rho & 15; return 8 * (i >> 2) + 4 * n + (i & 3); }

struct Unit { int pm, pn, e, nvalid, rowbase, lbase; };

struct DenseOrder {
    const char* A; const char* Bt; int nM, nN, nwg, G, c; size_t tstep;
    __device__ void init(const void* A_, const void* Bt_, int Mr, int N, int KB  , int G_, int c_) { A = (const char*)A_; Bt = (const char*)Bt_; nM = Mr / BM; nN = N / BM; nwg = nM * nN; G = G_; c = c_; tstep = (size_t)BM * KB; }
    __device__ __forceinline__ bool next(int i, Unit& u) const {
        const long L = (long)i * G + c; if (L >= nwg) return false;
        int wgid = (int)L; { const int q = nwg / NXCD, r = nwg % NXCD, xcd = wgid % NXCD, off = wgid / NXCD; wgid = (xcd < r ? xcd * (q + 1) : r * (q + 1) + (xcd - r) * q) + off; }
        const int nig = WGM * nN, gid = wgid / nig, fm = gid * WGM, gsz = (nM - fm) < WGM ? (nM - fm) : WGM;
        u.pm = fm + ((wgid % nig) % gsz); u.pn = (wgid % nig) / gsz; u.e = 0; u.nvalid = BM; u.rowbase = 0; u.lbase = 0; return true;
    }
    __device__ __forceinline__ unsigned a_off(const Unit& u) const { return (unsigned)u.pm * (unsigned)tstep; }
    __device__ __forceinline__ unsigned b_off(const Unit& u) const { return (unsigned)u.pn * (unsigned)tstep; }
    __device__ __forceinline__ unsigned row_tok(const Unit&, int) const { return 0u; }
};

struct MoeOrder {
    const char* A; const char* Bt; const unsigned* rowtok; const LAS int* tab; int tlo, nT, nN, nwg, G, c; size_t tstep, estride, rowbytes; bool gather;
    __device__ void init(const void* A_, const void* Bt_, const unsigned* rowtok_, const LAS int* tab_, int tlo_, int thi_, int N, int KB  , int G_, int c_, bool gather_) {
        A = (const char*)A_; Bt = (const char*)Bt_; rowtok = rowtok_; tab = tab_; tlo = tlo_; nT = thi_ - tlo_; if (nT < 0) nT = 0; nN = N / BM; nwg = nT * nN; G = G_; c = c_;
        tstep = (size_t)BM * KB; estride = (size_t)N * KB; rowbytes = (size_t)KB; gather = gather_; }
    __device__ __forceinline__ bool next(int i, Unit& u) const {
        const long L = (long)i * G + c; if (L >= nwg) return false;
        int wgid = (int)L; { const int q = nwg / NXCD, r = nwg % NXCD, xcd = wgid % NXCD, off = wgid / NXCD; wgid = (xcd < r ? xcd * (q + 1) : r * (q + 1) + (xcd - r) * q) + off; }
        const int nig = WGM * nN, gid = wgid / nig, fm = gid * WGM, gsz = (nT - fm) < WGM ? (nT - fm) : WGM;
        const int gt = tlo + fm + ((wgid % nig) % gsz), pn = (wgid % nig) / gsz;
        const int lane = threadIdx.x & 63;
        const int ts = (lane < 32) ? tab[lane] : 0x7fffffff;
        const unsigned long long mask = __ballot(ts <= gt);
        const int e = __builtin_popcountll(mask) - 1;
        const int j = gt - __builtin_amdgcn_readfirstlane(tab[e]);
        const int cnt = __builtin_amdgcn_readfirstlane(tab[40 + e]), es = __builtin_amdgcn_readfirstlane(tab[80 + e]);
        u.pm = gt; u.pn = pn; u.e = e; const int nv = cnt - 256 * j; u.nvalid = nv > 256 ? 256 : nv; u.rowbase = es + 256 * j; u.lbase = e * CAP + 256 * j; return true;
    }
    __device__ __forceinline__ unsigned a_off(const Unit& u) const { return gather ? 0u : (unsigned)u.rowbase * (unsigned)rowbytes; }
    __device__ __forceinline__ unsigned b_off(const Unit& u) const { return (unsigned)u.e * (unsigned)estride + (unsigned)u.pn * (unsigned)tstep; }
    __device__ __forceinline__ unsigned row_tok(const Unit& u, int r) const { const int rr = r < u.nvalid ? r : 0; return rowtok[u.lbase + rr]; }
};

typedef int v8i __attribute__((ext_vector_type(8))); typedef int v4i __attribute__((ext_vector_type(4)));
__device__ __forceinline__ v8i cat8(const bf16x8 a, const bf16x8 b) { return __builtin_shufflevector(__builtin_bit_cast(v4i, a), __builtin_bit_cast(v4i, b), 0, 1, 2, 3, 4, 5, 6, 7); }
template <class Epi, class Sched, bool GATHER, bool ALIGN_EPI, bool FP8>
__device__ __forceinline__ void gemm_phase(LAS unsigned char* lds, const int KB, const Sched& S, const Epi& E) {
    const int tid = threadIdx.x, wid = __builtin_amdgcn_readfirstlane(tid >> 6), lane = tid & 63, wr = wid >> 2, wc = wid & 3, fr = lane & 15, fq = lane >> 4;
    const int nt = KB / 128;
    int Rst[2], Cst[2]; unsigned voffB[2];
#pragma unroll
    for (int i = 0; i < 2; ++i) { int R, C; stage_rc(tid * 16 + i * 8192, R, C); Rst[i] = R; Cst[i] = C; const int Rb = (R & ~31) + perm32(R & 31); voffB[i] = (unsigned)(Rb * KB + C * 2); }
    const unsigned kstep = 128u;
    const unsigned hstep = (unsigned)HALF * (unsigned)KB;
    const __amdgpu_buffer_rsrc_t rsA = __builtin_amdgcn_make_buffer_rsrc((void*)S.A, 0, 0x7ffffff0, 0x00020000), rsB = __builtin_amdgcn_make_buffer_rsrc((void*)S.Bt, 0, 0x7ffffff0, 0x00020000);
    const unsigned ldsw = (unsigned)wid * 1024u;
    const int aoff = lds_byte(wr * 64 + fr, fq * 8), boff = lds_byte(wc * 32 + fr, fq * 8);
#define PG8_SA(b, h) (((b) * 2 + (h)) * HTB)
#define PG8_SB(b, h) ((4 + (b) * 2 + (h)) * HTB)
#define PG8_GLDS(rs, voff, soff, ldsoff) __builtin_amdgcn_raw_ptr_buffer_load_lds(rs, (LAS unsigned*)(lds + (ldsoff)), 16, (int)(voff), (int)(soff), 0, 0)
#define PG8_STAGE_B(bufoff, soff) do { PG8_GLDS(rsB, voffB[0], soff, (bufoff) + ldsw); PG8_GLDS(rsB, voffB[1], soff, (bufoff) + ldsw + 8192); } while (0)
#define PG8_STAGE_A(bufoff, soff, o0, o1) do { PG8_GLDS(rsA, o0, soff, (bufoff) + ldsw); PG8_GLDS(rsA, o1, soff, (bufoff) + ldsw + 8192); } while (0)
#define PG8_LDA(dst, b, h) do { _Pragma("unroll") for (int m = 0; m < 4; ++m) _Pragma("unroll") for (int k = 0; k < 2; ++k) dst[m][k] = *(const LAS bf16x8*)(lds + PG8_SA(b, h) + aoff + m * 2048 + k * 1024); } while (0)
#define PG8_LDB(dst, b, h) do { _Pragma("unroll") for (int n = 0; n < 2; ++n) _Pragma("unroll") for (int k = 0; k < 2; ++k) dst[n][k] = *(const LAS bf16x8*)(lds + PG8_SB(b, h) + boff + n * 2048 + k * 1024); } while (0)
#define PG8_MMA(ai, bj, At, Bt) do { __builtin_amdgcn_s_setprio(1); _Pragma("unroll") for (int m = 0; m < 4; ++m) _Pragma("unroll") for (int n = 0; n < 2; ++n) { \
        if constexpr (FP8) { const v8i b8_ = cat8(Bt[n][0], Bt[n][1]), a8_ = cat8(At[m][0], At[m][1]); asm volatile("v_mfma_f32_16x16x128_f8f6f4 %0, %1, %2, %0" : "+v"(acc[ai][bj][m][n]) : "v"(b8_), "v"(a8_)); } \
        else { _Pragma("unroll") for (int k = 0; k < 2; ++k) acc[ai][bj][m][n] = __builtin_amdgcn_mfma_f32_16x16x32_bf16(Bt[n][k], At[m][k], acc[ai][bj][m][n], 0, 0, 0); } } \
        __builtin_amdgcn_s_setprio(0); } while (0)
#define PG8_WAIT_V(n) asm volatile("s_waitcnt vmcnt(" #n ")" ::: "memory")
#define PG8_WAIT_L(n) asm volatile("s_waitcnt lgkmcnt(" #n ")" ::: "memory")
#define PG8_BAR __builtin_amdgcn_s_barrier()
#define PG8_SCHED __builtin_amdgcn_sched_barrier(0)
    Unit cur, nxt, nn; int ui = 0;
    if (!S.next(0, cur)) return;
    bool has_next = S.next(1, nxt);
    unsigned coff[2][2], noff[2][2];
#pragma unroll
    for (int h = 0; h < 2; ++h)
#pragma unroll
        for (int i = 0; i < 2; ++i) {
            if constexpr (GATHER) { coff[h][i] = S.row_tok(cur, h * HALF + Rst[i]) * (unsigned)KB + (unsigned)Cst[i] * 2u;
                                    noff[h][i] = has_next ? S.row_tok(nxt, h * HALF + Rst[i]) * (unsigned)KB + (unsigned)Cst[i] * 2u : coff[h][i]; }
            else { coff[h][i] = (unsigned)((h * HALF + Rst[i]) * KB + Cst[i] * 2); noff[h][i] = coff[h][i]; }
        }
    f32x4 acc[2][2][4][2];
#pragma unroll
    for (int a = 0; a < 2; ++a)
#pragma unroll
        for (int b = 0; b < 2; ++b)
#pragma unroll
            for (int m = 0; m < 4; ++m)
#pragma unroll
                for (int n = 0; n < 2; ++n) acc[a][b][m][n] = (f32x4){0.f, 0.f, 0.f, 0.f};
    bf16x8 At[4][2], B0[2][2], B1[2][2];
    unsigned cA = S.a_off(cur), cB = S.b_off(cur);
    PG8_STAGE_B(PG8_SB(0, 0), cB); PG8_STAGE_B(PG8_SB(0, 1), cB + hstep); PG8_STAGE_A(PG8_SA(0, 0), cA, coff[0][0], coff[0][1]); PG8_STAGE_A(PG8_SA(0, 1), cA, coff[1][0], coff[1][1]);
    if (wr == 1) PG8_BAR;
    PG8_WAIT_V(2); PG8_BAR;
    PG8_STAGE_B(PG8_SB(1, 0), cB + kstep); PG8_STAGE_A(PG8_SA(1, 0), cA + kstep, coff[0][0], coff[0][1]); PG8_STAGE_B(PG8_SB(1, 1), cB + hstep + kstep);
    PG8_WAIT_V(6); PG8_BAR;
    for (;;) {
        if constexpr (!GATHER) { if (ui > 0) has_next = S.next(ui + 1, nxt); }
        const unsigned nA = has_next ? S.a_off(nxt) : cA, nB = has_next ? S.b_off(nxt) : cB;
#pragma unroll 1
        for (int t = 0; t < nt; t += 2) {
            const bool last = (t == nt - 2);
            if constexpr (Epi::HAS_MID) { if (t == nt / 2) E.mid(acc, cur, wr, wc, fr, fq); }
            const unsigned a1 = cA + (unsigned)(t + 1) * kstep;
            const unsigned a2 = last ? nA : cA + (unsigned)(t + 2) * kstep, b2 = last ? nB : cB + (unsigned)(t + 2) * kstep;
            const unsigned a3 = a2 + kstep, b3 = b2 + kstep;
            unsigned x00, x01, x10, x11;
            if constexpr (GATHER) { x00 = last ? noff[0][0] : coff[0][0]; x01 = last ? noff[0][1] : coff[0][1]; x10 = last ? noff[1][0] : coff[1][0]; x11 = last ? noff[1][1] : coff[1][1]; }
            else { x00 = coff[0][0]; x01 = coff[0][1]; x10 = coff[1][0]; x11 = coff[1][1]; }
            PG8_LDB(B0, 0, 0); PG8_LDB(B1, 0, 1); PG8_SCHED; PG8_LDA(At, 0, 0); PG8_STAGE_A(PG8_SA(1, 1), a1, coff[1][0], coff[1][1]);
            PG8_WAIT_V(8); PG8_WAIT_L(0); PG8_BAR; PG8_MMA(0, 0, At, B0); PG8_MMA(0, 1, At, B1); PG8_BAR; PG8_SCHED;
            PG8_LDA(At, 0, 1); PG8_STAGE_B(PG8_SB(0, 0), b2); PG8_STAGE_B(PG8_SB(0, 1), b2 + hstep); PG8_STAGE_A(PG8_SA(0, 0), a2, x00, x01);
            PG8_WAIT_V(8); PG8_WAIT_L(0); PG8_BAR; PG8_MMA(1, 0, At, B0); PG8_MMA(1, 1, At, B1); PG8_BAR; PG8_SCHED;
            PG8_LDB(B0, 1, 0); PG8_LDB(B1, 1, 1); PG8_SCHED; PG8_LDA(At, 1, 0); PG8_STAGE_A(PG8_SA(0, 1), a2, x10, x11);
            PG8_WAIT_V(8); PG8_WAIT_L(0); PG8_BAR; PG8_MMA(0, 0, At, B0); PG8_MMA(0, 1, At, B1); PG8_BAR; PG8_SCHED;
            PG8_LDA(At, 1, 1); PG8_STAGE_B(PG8_SB(1, 0), b3); PG8_STAGE_B(PG8_SB(1, 1), b3 + hstep); PG8_STAGE_A(PG8_SA(1, 0), a3, x00, x01);
            PG8_WAIT_V(8); PG8_WAIT_L(0); PG8_BAR; PG8_MMA(1, 0, At, B0); PG8_MMA(1, 1, At, B1); PG8_BAR; PG8_SCHED;
        }
        if constexpr (FP8) asm volatile("s_nop 15\n\ts_nop 15" ::: "memory");
        if constexpr (ALIGN_EPI) { if (wr == 0) PG8_BAR; }
        bool has_nn = false; unsigned pend[2][2] = {{0u, 0u}, {0u, 0u}};
        if constexpr (GATHER) {
            has_nn = has_next && S.next(ui + 2, nn);
            if (has_nn) {
#pragma unroll
                for (int h = 0; h < 2; ++h)
#pragma unroll
                    for (int i = 0; i < 2; ++i) pend[h][i] = S.row_tok(nn, h * HALF + Rst[i]); }
        }
        E(acc, cur, wr, wc, fr, fq);
        if (!has_next) break;
#pragma unroll
        for (int a = 0; a < 2; ++a)
#pragma unroll
            for (int b = 0; b < 2; ++b)
#pragma unroll
                for (int m = 0; m < 4; ++m)
#pragma unroll
                    for (int n = 0; n < 2; ++n) acc[a][b][m][n] = (f32x4){0.f, 0.f, 0.f, 0.f};
        cur = nxt; cA = nA; cB = nB; ++ui;
        if constexpr (GATHER) {
#pragma unroll
            for (int h = 0; h < 2; ++h)
#pragma unroll
                for (int i = 0; i < 2; ++i) { coff[h][i] = noff[h][i]; if (has_nn) noff[h][i] = pend[h][i] * (unsigned)KB + (unsigned)Cst[i] * 2u; }
            nxt = nn; has_next = has_nn;
        }
        if constexpr (ALIGN_EPI) { if (wr == 1) PG8_BAR; }
    }
    PG8_WAIT_V(0);
    if constexpr (!ALIGN_EPI) { if (wr == 0) PG8_BAR; }
    PG8_BAR;
#undef PG8_SA
#undef PG8_SB
#undef PG8_GLDS
#undef PG8_STAGE_A
#undef PG8_STAGE_B
#undef PG8_LDA
#undef PG8_LDB
#undef PG8_MMA
#undef PG8_WAIT_V
#undef PG8_WAIT_L
#undef PG8_BAR
#undef PG8_SCHED
}

typedef f32x4 Acc[2][2][4][2];
#ifndef EPI_NT
#define EPI_NT 0
#endif
#if EPI_NT
#define NT_STORE(T, p, v) __builtin_nontemporal_store((T)(v), (T*)(p))
#else
#define NT_STORE(T, p, v) (*(T*)(p) = (v))
#endif
__device__ __forceinline__ u32x4 pack8(const f32x4 a, const f32x4 b) { u32x4 w; w.x = cvt_pk_bf16(a[0], a[1]); w.y = cvt_pk_bf16(a[2], a[3]); w.z = cvt_pk_bf16(b[0], b[1]); w.w = cvt_pk_bf16(b[2], b[3]); return w; }
__device__ __forceinline__ unsigned pk_fp8x4(float a, float b, float c, float d) { int w = __builtin_amdgcn_cvt_pk_fp8_f32(a, b, 0, false); w = __builtin_amdgcn_cvt_pk_fp8_f32(c, d, w, true); return (unsigned)w; }
__device__ __forceinline__ u32x2 pack8_fp8(const f32x4 a, const f32x4 b) { u32x2 w; w.x = pk_fp8x4(a[0], a[1], a[2], a[3]); w.y = pk_fp8x4(b[0], b[1], b[2], b[3]); return w; }
__device__ __forceinline__ void unpack8(const u32x4 w, f32x4& a, f32x4& b) { a = (f32x4){bf_lo(w.x), bf_hi(w.x), bf_lo(w.y), bf_hi(w.y)}; b = (f32x4){bf_lo(w.z), bf_hi(w.z), bf_lo(w.w), bf_hi(w.w)}; }

struct EpiInProj {
    static constexpr bool HAS_MID = false;
    bf16_t *U, *Bg, *Q, *Kk, *V, *R, *SB; const float *qn, *kn;
    __device__ __forceinline__ void operator()(const Acc& acc, const Unit& u, int wr, int wc, int fr, int fq) const {
        const int t = u.pn; const size_t row0 = (size_t)u.pm * BM + wr * 64 + fr; const int cb = wc * 32 + 8 * fq;
        if (t < 4) {
#pragma unroll
            for (int ai = 0; ai < 2; ++ai)
#pragma unroll
                for (int m = 0; m < 4; ++m) { const size_t r = row0 + ai * HALF + m * 16;
                    NT_STORE(u32x4, (U + r * CONVW + t * 128 + cb), (pack8(acc[ai][0][m][0] * acc[ai][1][m][0], acc[ai][0][m][1] * acc[ai][1][m][1]))); }
        } else if (t < 6 || t == 10 || t == 11) {
            bf16_t* base = (t < 6) ? Bg + (t - 4) * 256 : V + (t - 10) * 256;
#pragma unroll
            for (int ai = 0; ai < 2; ++ai)
#pragma unroll
                for (int m = 0; m < 4; ++m) { const size_t r = row0 + ai * HALF + m * 16;
#pragma unroll
                    for (int bj = 0; bj < 2; ++bj) NT_STORE(u32x4, (base + r * 512 + bj * HALF + cb), (pack8(acc[ai][bj][m][0], acc[ai][bj][m][1]))); }
        } else if (t < 10) {
            const bool isq = t < 8; bf16_t* base = isq ? Q : Kk; const float* gn = isq ? qn : kn; const float sc = isq ? 0.125f * LOG2E : 1.0f;
            const int hh = 4 * (t & 1) + wc;
            f32x4 g[2][2];
#pragma unroll
            for (int bj = 0; bj < 2; ++bj) { g[bj][0] = *(const f32x4*)(gn + 32 * bj + 8 * fq) * sc; g[bj][1] = *(const f32x4*)(gn + 32 * bj + 8 * fq + 4) * sc; }
#pragma unroll
            for (int ai = 0; ai < 2; ++ai)
#pragma unroll
                for (int m = 0; m < 4; ++m) { const size_t r = row0 + ai * HALF + m * 16; float ss = 0.f;
#pragma unroll
                    for (int bj = 0; bj < 2; ++bj)
#pragma unroll
                        for (int n = 0; n < 2; ++n) { const f32x4 v = acc[ai][bj][m][n]; ss += (v[0] * v[0] + v[1] * v[1]) + (v[2] * v[2] + v[3] * v[3]); }
                    ss += __shfl_xor(ss, 16); ss += __shfl_xor(ss, 32);
                    const float rinv = __builtin_amdgcn_rsqf(ss * (1.0f / 64.0f) + NORM_EPS);
#pragma unroll
                    for (int bj = 0; bj < 2; ++bj) NT_STORE(u32x4, (base + r * 512 + hh * 64 + 32 * bj + 8 * fq), (pack8(acc[ai][bj][m][0] * rinv * g[bj][0], acc[ai][bj][m][1] * rinv * g[bj][1]))); }
        } else {
            const int gi = t - 12;
#pragma unroll
            for (int ai = 0; ai < 2; ++ai)
#pragma unroll
                for (int m = 0; m < 4; ++m) { const size_t r = row0 + ai * HALF + m * 16; f32x4 rr[2], sb[2];
#pragma unroll
                    for (int n = 0; n < 2; ++n)
#pragma unroll
                        for (int j = 0; j < 4; ++j) { float a = acc[ai][0][m][n][j], b = acc[ai][1][m][n][j];
                            a = fminf(fmaxf(a, -30.f), 30.f); b = fminf(fmaxf(b, -30.f), 30.f);
                            const float ea = __builtin_amdgcn_exp2f(-a * LOG2E), eb = __builtin_amdgcn_exp2f(-b * LOG2E);
                            const float ia = __builtin_amdgcn_rcpf(1.f + ea), ib = __builtin_amdgcn_rcpf(1.f + eb);
                            rr[n][j] = (1.f + eb) * ia; sb[n][j] = ib; }
                    NT_STORE(u32x4, (R + r * D + gi * 128 + cb), (pack8(rr[0], rr[1]))); NT_STORE(u32x4, (SB + r * D + gi * 128 + cb), (pack8(sb[0], sb[1]))); }
        }
    }
};
struct EpiMix {
    static constexpr bool HAS_MID = true;
    const bf16_t *R, *SB; bf16_t* O;
    __device__ __forceinline__ void mid(Acc& acc, const Unit& u, int wr, int wc, int fr, int fq) const {
        const size_t row0 = (size_t)u.pm * BM + wr * 64 + fr; const int col0 = u.pn * BM + wc * 32 + 8 * fq;
#pragma unroll
        for (int ai = 0; ai < 2; ++ai)
#pragma unroll
            for (int m = 0; m < 4; ++m) { const size_t r = row0 + ai * HALF + m * 16;
#pragma unroll
                for (int bj = 0; bj < 2; ++bj) { f32x4 a, b; unpack8(*(const u32x4*)(R + r * D + col0 + bj * HALF), a, b); acc[ai][bj][m][0] *= a; acc[ai][bj][m][1] *= b; } }
    }
    __device__ __forceinline__ void operator()(const Acc& acc, const Unit& u, int wr, int wc, int fr, int fq) const {
        const size_t row0 = (size_t)u.pm * BM + wr * 64 + fr; const int col0 = u.pn * BM + wc * 32 + 8 * fq;
#pragma unroll
        for (int ai = 0; ai < 2; ++ai)
#pragma unroll
            for (int m = 0; m < 4; ++m) { const size_t r = row0 + ai * HALF + m * 16;
#pragma unroll
                for (int bj = 0; bj < 2; ++bj) { f32x4 a, b; unpack8(*(const u32x4*)(SB + r * D + col0 + bj * HALF), a, b);
                    NT_STORE(u32x4, (O + r * D + col0 + bj * HALF), (pack8(acc[ai][bj][m][0] * a, acc[ai][bj][m][1] * b))); } }
    }
};
struct EpiResid {
    static constexpr bool HAS_MID = false;
    const float* X; bf16_t* O;
    __device__ __forceinline__ void operator()(const Acc& acc, const Unit& u, int wr, int wc, int fr, int fq) const {
        const size_t row0 = (size_t)u.pm * BM + wr * 64 + fr; const int col0 = u.pn * BM + wc * 32 + 8 * fq;
#pragma unroll
        for (int ai = 0; ai < 2; ++ai)
#pragma unroll
            for (int m = 0; m < 4; ++m) { const size_t r = row0 + ai * HALF + m * 16;
#pragma unroll
                for (int bj = 0; bj < 2; ++bj) { const size_t o = r * D + col0 + bj * HALF;
                    const f32x4 v0 = *(const f32x4*)(X + o) + acc[ai][bj][m][0], v1 = *(const f32x4*)(X + o + 4) + acc[ai][bj][m][1];
                    NT_STORE(u32x4, (O + o), (pack8(v0, v1))); } }
    }
};
struct EpiSwiglu {
    static constexpr bool HAS_MID = false;
    const float *bg, *bu; unsigned char* act;
    __device__ __forceinline__ void operator()(const Acc& acc, const Unit& u, int wr, int wc, int fr, int fq) const {
        asm volatile("" : "+v"(fr), "+v"(fq));
        const int f0 = u.pn * 128 + wc * 32 + 8 * fq;
        f32x4 g0 = *(const f32x4*)(bg + u.e * FF + f0), g1 = *(const f32x4*)(bg + u.e * FF + f0 + 4), u0 = *(const f32x4*)(bu + u.e * FF + f0), u1 = *(const f32x4*)(bu + u.e * FF + f0 + 4);
#pragma unroll
        for (int ai = 0; ai < 2; ++ai)
#pragma unroll
            for (int m = 0; m < 4; ++m) { const int rl = ai * HALF + wr * 64 + m * 16 + fr;
                if (rl < u.nvalid) {
                    const float rs = WINV;
                    f32x4 o[2];
#pragma unroll
                    for (int n = 0; n < 2; ++n)
#pragma unroll
                        for (int j = 0; j < 4; ++j) { const float gb = n ? g1[j] : g0[j], ub = n ? u1[j] : u0[j];
                            float g = fminf(acc[ai][0][m][n][j] * rs + gb, 7.0f); float uu = fminf(fmaxf(acc[ai][1][m][n][j] * rs + ub, -7.0f), 7.0f);
                            const float sg = __builtin_amdgcn_rcpf(1.f + __builtin_amdgcn_exp2f(-1.702f * LOG2E * g));
                            o[n][j] = g * sg * (uu + 1.0f); }
                    NT_STORE(u32x2, (act + (size_t)(u.rowbase + rl) * FF + f0), (pack8_fp8(o[0], o[1]))); } }
        asm volatile("" :: "v"(g0), "v"(g1), "v"(u0), "v"(u1));
    }
};
struct EpiDown {
    static constexpr bool HAS_MID = false;
    const float* bd; unsigned char* Y;
    __device__ __forceinline__ void operator()(const Acc& acc, const Unit& u, int wr, int wc, int fr, int fq) const {
        asm volatile("" : "+v"(fr), "+v"(fq));
        const int col0 = u.pn * BM + wc * 32 + 8 * fq;
        unsigned char* yb = Y + (size_t)u.rowbase * D;
        f32x4 b[2][2];
#pragma unroll
        for (int bj = 0; bj < 2; ++bj) { b[bj][0] = *(const f32x4*)(bd + u.e * D + col0 + bj * HALF); b[bj][1] = *(const f32x4*)(bd + u.e * D + col0 + bj * HALF + 4); }
#pragma unroll
        for (int ai = 0; ai < 2; ++ai)
#pragma unroll
            for (int m = 0; m < 4; ++m) { const int rl = ai * HALF + wr * 64 + m * 16 + fr;
                if (rl < u.nvalid) {
#pragma unroll
                    for (int bj = 0; bj < 2; ++bj) NT_STORE(u32x2, (yb + (size_t)rl * D + col0 + bj * HALF), (pack8_fp8(acc[ai][bj][m][0] * WINV + b[bj][0], acc[ai][bj][m][1] * WINV + b[bj][1]))); } }
        asm volatile("" :: "v"(b[0][0]), "v"(b[0][1]), "v"(b[1][0]), "v"(b[1][1]));
    }
};
}

struct Args { const float* in[19]; float* out; unsigned char* ws; int ph_lo, ph_hi; };
struct Frame {
    LAS unsigned char* lds; volatile LAS unsigned* MISC; unsigned* ctl;
    int tid, lane, wave, G, bx;
    const float *x, *norm_mix, *w_in, *conv_w, *w_out_conv, *q_norm, *k_norm, *rpb, *w_out_attn, *w_o, *norm_ffn, *w_router, *b_router, *w_gate, *b_gate, *w_up, *b_up, *w_down, *b_down;
    float* out; unsigned char* ws;
};

__device__ __forceinline__ float wave_sum(float v) {
#pragma unroll
    for (int o = 1; o < 64; o <<= 1) v += __shfl_xor(v, o);
    return v;
}

__device__ __forceinline__ s16x4 tr_read(const LAS unsigned char* p) { return __builtin_bit_cast(s16x4, __builtin_amdgcn_ds_read_tr16_b64_v4i16((LAS s16x4*)p)); }
using pg8::pk_fp8x4;
__device__ __forceinline__ float bf2f(short h) { return __uint_as_float(((unsigned)(unsigned short)h) << 16); }
template <bool FP8>
__device__ __forceinline__ void p0_item(const float* W, int ldw, int k0, int c0a, int c0b  , unsigned char* dst  , int ldd  , const float* ks, float mul, LAS unsigned char* T, int lane) {
    constexpr int RS = 144;
    const int lq = lane >> 4, li = lane & 15, c0 = (li < 8 ? c0a : c0b) + 4 * (li & 7);
    f32x4 v[16];
#pragma unroll
    for (int i = 0; i < 16; ++i) v[i] = *(const f32x4*)(W + (size_t)(k0 + 4 * i + lq) * ldw + c0);
#pragma unroll
    for (int i = 0; i < 16; ++i) { const int k = 4 * i + lq; const float sc = ks ? mul * ks[k0 + k] : mul; const f32x4 y = v[i] * sc;
        u32x2 w; w.x = cvt_pk_bf16(y[0], y[1]); w.y = cvt_pk_bf16(y[2], y[3]); *(LAS u32x2*)(T + k * RS + 8 * li) = w; }
    LDS_WAIT(); asm volatile("" ::: "memory");
    const LAS unsigned char* tb = T + (li >> 2) * RS + (li & 3) * 8;
#pragma unroll
    for (int nb = 0; nb < 4; ++nb) {
        if constexpr (FP8) {
            s16x4 t[4];
#pragma unroll
            for (int j = 0; j < 4; ++j) t[j] = tr_read(tb + (16 * lq + 4 * j) * RS + nb * 32);
            u32x4 o;
            o.x = pk_fp8x4(bf2f(t[0][0]), bf2f(t[0][1]), bf2f(t[0][2]), bf2f(t[0][3])); o.y = pk_fp8x4(bf2f(t[1][0]), bf2f(t[1][1]), bf2f(t[1][2]), bf2f(t[1][3]));
            o.z = pk_fp8x4(bf2f(t[2][0]), bf2f(t[2][1]), bf2f(t[2][2]), bf2f(t[2][3])); o.w = pk_fp8x4(bf2f(t[3][0]), bf2f(t[3][1]), bf2f(t[3][2]), bf2f(t[3][3]));
            *(u32x4*)(dst + (size_t)(16 * nb + li) * ldd + 16 * lq) = o;
        } else {
#pragma unroll
            for (int hf = 0; hf < 2; ++hf) { const int c = lq + 4 * hf;
                const s16x4 lo = tr_read(tb + (8 * c) * RS + nb * 32), hi = tr_read(tb + (8 * c + 4) * RS + nb * 32);
                const bf16x8 o = {lo[0], lo[1], lo[2], lo[3], hi[0], hi[1], hi[2], hi[3]};
                *(bf16x8*)(dst + (size_t)(16 * nb + li) * ldd + 16 * c) = o; }
        }
    }
    LDS_WAIT(); asm volatile("" ::: "memory");
}
__device__ __forceinline__ int inproj_srccol(int n0) {
    const int t = n0 >> 8, bj = (n0 >> 7) & 1, w = (n0 >> 5) & 3;
    if (t < 4) return (bj ? 1024 : 0) + 128 * t + 32 * w;
    if (t < 6) return 512 + 256 * (t - 4) + 128 * bj + 32 * w;
    if (t < 8) return 1536 + (4 * (t - 6) + w) * 64 + 32 * bj;
    if (t < 10) return 2048 + (4 * (t - 8) + w) * 64 + 32 * bj;
    if (t < 12) return 2560 + 256 * (t - 10) + 128 * bj + 32 * w;
    return (bj ? 4096 : 3072) + 128 * (t - 12) + 32 * w;
}
__device__ __forceinline__ void p0_prologue(Frame& F) {
    LAS unsigned char* T = F.lds + F.wave * 9216;
    const int gw = F.bx * NWAVES + F.wave, NGW = F.G * NWAVES, lane = F.lane;
    unsigned char* Win = F.ws + WS_WIN; unsigned char* Wca = F.ws + WS_WCA; unsigned char* Wo = F.ws + WS_WO; unsigned char* Wd = F.ws + WS_WD; unsigned char* Wgu = F.ws + WS_WGU;
    constexpr int I_IN = 16 * 80, I_CA = 2 * 8 * 16, I_O = 16 * 16, I_GU = NE * 16 * 32, I_D = NE * 16 * 16;
    constexpr int NITEMS = I_IN + I_CA + I_O + I_GU + I_D;
    for (int it = gw; it < NITEMS; it += NGW) {
        int r = it;
        if (r < I_IN) { const int kb = r / 80, nb = r % 80; p0_item<false>(F.w_in, PROJW, 64 * kb, inproj_srccol(64 * nb), inproj_srccol(64 * nb + 32), Win + ((size_t)(64 * nb) * D + 64 * kb) * 2, D * 2, nullptr, 1.f, T, lane); continue; } r -= I_IN;
        if (r < I_CA) { const int s = r / 128, q = r % 128, kb = q / 16, nb = q % 16; p0_item<false>(s ? F.w_out_attn : F.w_out_conv, D, 64 * kb, 64 * nb, 64 * nb + 32, Wca + ((size_t)(64 * nb) * D + 512 * s + 64 * kb) * 2, D * 2, nullptr, 1.f, T, lane); continue; } r -= I_CA;
        if (r < I_O) { const int kb = r / 16, nb = r % 16; p0_item<false>(F.w_o, D, 64 * kb, 64 * nb, 64 * nb + 32, Wo + ((size_t)(64 * nb) * D + 64 * kb) * 2, D * 2, nullptr, 1.f, T, lane); continue; } r -= I_O;
        if (r < I_GU) { const int e = r / 512, q = r % 512, kb = q / 32, nb = q % 32, n0 = 64 * nb, pn = n0 >> 8, bj = (n0 >> 7) & 1, c64 = n0 & 127;
            p0_item<true>((bj ? F.w_up : F.w_gate) + (size_t)e * D * FF, FF, 64 * kb, 128 * pn + c64, 128 * pn + c64 + 32, Wgu + ((size_t)e * 2048 + n0) * D + 64 * kb, D, F.norm_ffn, WSCALE, T, lane); continue; } r -= I_GU;
        { const int e = r / 256, q = r % 256, kb = q / 16, nb = q % 16; p0_item<true>(F.w_down + (size_t)e * FF * D, D, 64 * kb, 64 * nb, 64 * nb + 32, Wd + ((size_t)e * D + 64 * nb) * FF + 64 * kb, FF, nullptr, WSCALE, T, lane); }
    }
    { bf16_t* wh = (bf16_t*)(F.ws + WS_WRH); bf16_t* wl = (bf16_t*)(F.ws + WS_WRL);
      for (int i = F.bx * NTHREADS + F.tid; i < NE * D; i += F.G * NTHREADS) { const int e = i >> 10, k = i & 1023; const float v = F.w_router[k * NE + e] * F.norm_ffn[k];
          const unsigned h = cvt_pk_bf16(v, 0.f) & 0xffffu; const float lo = v - __uint_as_float(h << 16); wh[i] = (bf16_t)h; wl[i] = (bf16_t)(cvt_pk_bf16(lo, 0.f) & 0xffffu); } }
    bf16_t* Hb = (bf16_t*)F.out;
    for (int m = gw; m < M; m += NGW) {
        const f32x4* xr = (const f32x4*)(F.x + (size_t)m * D) + lane; f32x4 v[4]; float s = 0.f;
#pragma unroll
        for (int j = 0; j < 4; ++j) { v[j] = xr[64 * j]; s += (v[j][0] * v[j][0] + v[j][1] * v[j][1]) + (v[j][2] * v[j][2] + v[j][3] * v[j][3]); }
        const float rstd = 1.0f / sqrtf(wave_sum(s) * (1.f / D) + NORM_EPS);
        unsigned long long* o8 = (unsigned long long*)(Hb + (size_t)m * D) + lane;
#pragma unroll
        for (int j = 0; j < 4; ++j) { const f32x4 g = *((const f32x4*)F.norm_mix + lane + 64 * j); const f32x4 y = v[j] * rstd * g;
            o8[64 * j] = (unsigned long long)cvt_pk_bf16(y[0], y[1]) | ((unsigned long long)cvt_pk_bf16(y[2], y[3]) << 32); }
    }
}

__device__ __forceinline__ void p2_conv(Frame& F) {
    const bf16_t* U = (const bf16_t*)(F.ws + WS_U); const bf16_t* Bg = (const bf16_t*)(F.ws + WS_BG); bf16_t* za = (bf16_t*)F.out + (size_t)M * D;
    const int c8 = (F.tid & 63) * 8;
    const f32x4 w00 = *(const f32x4*)(F.conv_w + c8), w01 = *(const f32x4*)(F.conv_w + c8 + 4), w10 = *(const f32x4*)(F.conv_w + CONVW + c8), w11 = *(const f32x4*)(F.conv_w + CONVW + c8 + 4),
                w20 = *(const f32x4*)(F.conv_w + 2 * CONVW + c8), w21 = *(const f32x4*)(F.conv_w + 2 * CONVW + c8 + 4);
    const int stride = F.G * NTHREADS;
    for (int it0 = F.bx * NTHREADS + F.tid; it0 < M * 64; it0 += 4 * stride) {
        u32x4 u0[4], um[4], up[4], bb[4];
#pragma unroll
        for (int j = 0; j < 4; ++j) { const int it = it0 + j * stride; const bool ok = it < M * 64; const int t = ok ? it >> 6 : 0, sq = t & (SEQ - 1);
            const u32x4 z4 = {0u, 0u, 0u, 0u};
            u0[j] = *(const u32x4*)(U + (size_t)t * CONVW + c8); um[j] = sq > 0 ? *(const u32x4*)(U + (size_t)(t - 1) * CONVW + c8) : z4; up[j] = sq < SEQ - 1 ? *(const u32x4*)(U + (size_t)(t + 1) * CONVW + c8) : z4;
            bb[j] = *(const u32x4*)(Bg + (size_t)t * CONVW + c8); }
#pragma unroll
        for (int j = 0; j < 4; ++j) { const int it = it0 + j * stride; if (it < M * 64) { const int t = it >> 6;
            f32x4 a0, a1, m0, m1, p0, p1, b0, b1; pg8::unpack8(u0[j], a0, a1); pg8::unpack8(um[j], m0, m1); pg8::unpack8(up[j], p0, p1); pg8::unpack8(bb[j], b0, b1);
            const f32x4 z0 = b0 * (w00 * m0 + w10 * a0 + w20 * p0), z1 = b1 * (w01 * m1 + w11 * a1 + w21 * p1);
            *(u32x4*)(za + (size_t)t * D + c8) = pg8::pack8(z0, z1); } }
    }
}
__device__ __forceinline__ void p2_attn(Frame& F) {
    const bf16_t* Q = (const bf16_t*)(F.ws + WS_Q); const bf16_t* Kp = (const bf16_t*)(F.ws + WS_K); const bf16_t* V = (const bf16_t*)(F.ws + WS_V);
    bf16_t* za = (bf16_t*)F.out + (size_t)M * D;
    LAS unsigned char* Ks = F.lds; LAS unsigned char* Vs = F.lds + 65536; LAS float* rpbl = (LAS float*)(F.lds + LDS_X);
    for (int i = F.tid; i < NH * 15 * 31; i += NTHREADS) rpbl[i] = F.rpb[i] * LOG2E;
    const int lane = F.lane, g = lane >> 4, l15 = lane & 15;
    constexpr int NU = NB * NH * 32;
    u32x4 kv[8], vv[8]; bf16x8 qn[2];
#define ATT_LOAD(UN) do { const int cb_ = (UN) & 3, rb_ = ((UN) >> 2) & 7, h_ = ((UN) >> 5) & 7, b_ = (UN) >> 8; const int kr_ = clampi(8 * rb_ - 4, 0, 48), kc_ = clampi(16 * cb_ - 8, 0, 32); \
        _Pragma("unroll") for (int i = 0; i < 8; ++i) { const int cid = F.tid + NTHREADS * i, key = cid >> 3, c = cid & 7; const size_t tok = (size_t)b_ * SEQ + (kr_ + (key >> 5)) * 64 + kc_ + (key & 31); \
            kv[i] = *(const u32x4*)(Kp + tok * ATTW + h_ * HD + c * 8); vv[i] = *(const u32x4*)(V + tok * ATTW + h_ * HD + c * 8); } \
        { const size_t qt_ = (size_t)b_ * SEQ + (8 * rb_ + F.wave) * 64 + 16 * cb_ + l15; qn[0] = *(const bf16x8*)(Q + qt_ * ATTW + h_ * HD + 8 * g); qn[1] = *(const bf16x8*)(Q + qt_ * ATTW + h_ * HD + 32 + 8 * g); } } while (0)
    if (F.bx < NU) ATT_LOAD(F.bx);
    for (int un = F.bx; un < NU; un += F.G) {
        const int cbk = un & 3, rb = (un >> 2) & 7, h = (un >> 5) & 7, b = un >> 8;
        const int kr0 = clampi(8 * rb - 4, 0, 48), kc0 = clampi(16 * cbk - 8, 0, 32);
        __syncthreads();
#pragma unroll
        for (int i = 0; i < 8; ++i) { const int cid = F.tid + NTHREADS * i, key = cid >> 3, c = cid & 7;
            *(LAS u32x4*)(Ks + key * 128 + ((c ^ ((key >> 1) & 7)) << 4)) = kv[i]; *(LAS u32x4*)(Vs + key * 128 + ((c ^ (((key >> 1) & 3) << 1)) << 4)) = vv[i]; }
        __syncthreads();
        const int qr = 8 * rb + F.wave, rs = clampi(qr - 4, 0, 56), krs = rs - kr0, qc = 16 * cbk + l15, cs = clampi(qc - 8, 0, 48);
        const size_t qtok = (size_t)b * SEQ + qr * 64 + qc;
        const bf16x8 qf[2] = {qn[0], qn[1]};
        if (un + F.G < NU) ATT_LOAD(un + F.G);
        f32x4 sc[8][2];
#pragma unroll
        for (int jr = 0; jr < 8; ++jr)
#pragma unroll
            for (int f = 0; f < 2; ++f) { const int key = (krs + jr) * 32 + 16 * f + l15; f32x4 a = {0.f, 0.f, 0.f, 0.f};
#pragma unroll
                for (int ks = 0; ks < 2; ++ks) { const bf16x8 kf = *(const LAS bf16x8*)(Ks + key * 128 + (((4 * ks + g) ^ ((key >> 1) & 7)) << 4)); a = __builtin_amdgcn_mfma_f32_16x16x32_bf16(kf, qf[ks], a, 0, 0, 0); }
                sc[jr][f] = a; }
        float mx = -1e30f;
        const LAS float* rp = rpbl + h * 465;
#pragma unroll
        for (int jr = 0; jr < 8; ++jr) { const int ridx = rs + jr - qr + 7;
#pragma unroll
            for (int f = 0; f < 2; ++f)
#pragma unroll
                for (int r = 0; r < 4; ++r) { const int kc = kc0 + 16 * f + 4 * g + r; const bool valid = (kc >= cs) && (kc < cs + 16); const int cidx = clampi(kc - qc + 15, 0, 30);
                    const float s = valid ? sc[jr][f][r] + rp[ridx * 31 + cidx] : -1e30f; sc[jr][f][r] = s; mx = fmaxf(mx, s); } }
        mx = fmaxf(mx, __shfl_xor(mx, 16)); mx = fmaxf(mx, __shfl_xor(mx, 32));
        float sum = 0.f;
#pragma unroll
        for (int jr = 0; jr < 8; ++jr)
#pragma unroll
            for (int f = 0; f < 2; ++f)
#pragma unroll
                for (int r = 0; r < 4; ++r) { const float p = __builtin_amdgcn_exp2f(sc[jr][f][r] - mx); sc[jr][f][r] = p; sum += p; }
        sum += __shfl_xor(sum, 16); sum += __shfl_xor(sum, 32);
        f32x4 o[4];
#pragma unroll
        for (int db = 0; db < 4; ++db) o[db] = (f32x4){0.f, 0.f, 0.f, 0.f};
        const int q4 = l15 >> 2, p4 = lane & 3;
#pragma unroll
        for (int jr = 0; jr < 8; ++jr) {
            const u32x4 pw = pg8::pack8(sc[jr][0], sc[jr][1]); const bf16x8 pb = __builtin_bit_cast(bf16x8, pw);
            const int key1 = (krs + jr) * 32 + 4 * g + q4, key2 = key1 + 16;
#pragma unroll
            for (int db = 0; db < 4; ++db) { const int ch = 2 * db + (p4 >> 1);
                const s16x4 lo = tr_read(Vs + key1 * 128 + ((ch ^ (((key1 >> 1) & 3) << 1)) << 4) + 8 * (p4 & 1));
                const s16x4 hi = tr_read(Vs + key2 * 128 + ((ch ^ (((key2 >> 1) & 3) << 1)) << 4) + 8 * (p4 & 1));
                const bf16x8 vf = {lo[0], lo[1], lo[2], lo[3], hi[0], hi[1], hi[2], hi[3]};
                o[db] = __builtin_amdgcn_mfma_f32_16x16x32_bf16(vf, pb, o[db], 0, 0, 0); } }
        const float inv = 1.0f / sum;
#pragma unroll
        for (int db = 0; db < 4; ++db) { const f32x4 v = o[db] * inv; u32x2 w; w.x = cvt_pk_bf16(v[0], v[1]); w.y = cvt_pk_bf16(v[2], v[3]);
            *(u32x2*)(za + qtok * D + 512 + h * HD + 16 * db + 4 * g) = w; }
    }
    __syncthreads();
}

__device__ __forceinline__ void p5_router(Frame& F) {
    constexpr int RS = 2064;
    LAS unsigned char* Th = F.lds; LAS unsigned char* Tl = F.lds + 32 * RS;
    LAS float* lg = (LAS float*)(F.lds + LDS_X + F.wave * 2112);
    LAS unsigned* lcnt = (LAS unsigned*)(F.lds + LDS_CNT); LAS unsigned* lbase = lcnt + 32;
    const bf16_t* wh = (const bf16_t*)(F.ws + WS_WRH); const bf16_t* wl = (const bf16_t*)(F.ws + WS_WRL);
    for (int i = F.tid; i < 32 * 128; i += NTHREADS) { const int e = i >> 7, c = i & 127; *(LAS u32x4*)(Th + e * RS + c * 16) = *(const u32x4*)(wh + e * D + c * 8); *(LAS u32x4*)(Tl + e * RS + c * 16) = *(const u32x4*)(wl + e * D + c * 8); }
    const int lane = F.lane, g = lane >> 4, l15 = lane & 15;
    unsigned* rowtok = (unsigned*)(F.ws + WS_ROWTOK); unsigned* tokpos = (unsigned*)(F.ws + WS_TOKPOS); float* tokgate = (float*)(F.ws + WS_TOKGATE); float* rstd2 = (float*)(F.ws + WS_RSTD2);
    for (int ch = F.bx; ch < M / 128; ch += F.G) {
        if (F.tid < 32) lcnt[F.tid] = 0u;
        __syncthreads();
        const int t0 = ch * 128 + F.wave * 16;
        f32x4 a0 = {0.f, 0.f, 0.f, 0.f}, a1 = {0.f, 0.f, 0.f, 0.f}; float ssq = 0.f;
        const bf16_t* xp = (const bf16_t*)(F.ws + WS_X1) + (size_t)(t0 + l15) * D + 8 * g;
#pragma unroll 8
        for (int s = 0; s < 32; ++s) {
            const u32x4 xw = *(const u32x4*)(xp + 32 * s); f32x4 v0, v1; pg8::unpack8(xw, v0, v1);
            ssq += (v0[0] * v0[0] + v0[1] * v0[1]) + (v0[2] * v0[2] + v0[3] * v0[3]) + (v1[0] * v1[0] + v1[1] * v1[1]) + (v1[2] * v1[2] + v1[3] * v1[3]);
            const bf16x8 xh = __builtin_bit_cast(bf16x8, xw);
            const int ko = (32 * s + 8 * g) * 2;
            const bf16x8 bh0 = *(const LAS bf16x8*)(Th + l15 * RS + ko), bh1 = *(const LAS bf16x8*)(Th + (16 + l15) * RS + ko), bl0 = *(const LAS bf16x8*)(Tl + l15 * RS + ko), bl1 = *(const LAS bf16x8*)(Tl + (16 + l15) * RS + ko);
            a0 = __builtin_amdgcn_mfma_f32_16x16x32_bf16(xh, bh0, a0, 0, 0, 0); a0 = __builtin_amdgcn_mfma_f32_16x16x32_bf16(xh, bl0, a0, 0, 0, 0);
            a1 = __builtin_amdgcn_mfma_f32_16x16x32_bf16(xh, bh1, a1, 0, 0, 0); a1 = __builtin_amdgcn_mfma_f32_16x16x32_bf16(xh, bl1, a1, 0, 0, 0);
        }
        ssq += __shfl_xor(ssq, 16); ssq += __shfl_xor(ssq, 32);
        const float rstd = 1.0f / sqrtf(ssq * (1.f / D) + NORM_EPS);
        { unsigned char* x8 = F.ws + WS_XB + (size_t)(t0 + l15) * D + 8 * g;
#pragma unroll 1
          for (int s0 = 0; s0 < 32; s0 += 16) { u32x4 xw[16];
#pragma unroll
              for (int j = 0; j < 16; ++j) xw[j] = *(const u32x4*)(xp + 32 * (s0 + j));
#pragma unroll
              for (int j = 0; j < 16; ++j) { f32x4 v0, v1; pg8::unpack8(xw[j], v0, v1); *(u32x2*)(x8 + 32 * (s0 + j)) = pg8::pack8_fp8(v0 * rstd, v1 * rstd); } } }
        const float br0 = F.b_router[l15], br1 = F.b_router[16 + l15];
#pragma unroll
        for (int r = 0; r < 4; ++r) { const float rsr = __shfl(rstd, 4 * g + r); lg[(4 * g + r) * 33 + l15] = a0[r] * rsr + br0; lg[(4 * g + r) * 33 + 16 + l15] = a1[r] * rsr + br1; }
        LDS_WAIT(); asm volatile("" ::: "memory");
        int sel_e[4] = {0, 0, 0, 0}; float sel_g[4] = {0.f, 0.f, 0.f, 0.f}; unsigned lpos[4] = {0u, 0u, 0u, 0u};
        if (lane < 16) {
            float v[32];
#pragma unroll
            for (int e = 0; e < 32; ++e) v[e] = lg[lane * 33 + e];
            float tv[4];
#pragma unroll
            for (int k = 0; k < 4; ++k) { float best = -3.0e38f; int bi = 0;
#pragma unroll
                for (int e = 0; e < 32; ++e) { if (v[e] > best) { best = v[e]; bi = e; } }
#pragma unroll
                for (int e = 0; e < 32; ++e) { if (e == bi) v[e] = -3.0e38f; }
                tv[k] = best; sel_e[k] = bi; }
            float den = 0.f;
#pragma unroll
            for (int k = 0; k < 4; ++k) { sel_g[k] = __builtin_amdgcn_exp2f((tv[k] - tv[0]) * LOG2E); den += sel_g[k]; }
            const float idn = 1.0f / den;
#pragma unroll
            for (int k = 0; k < 4; ++k) { sel_g[k] *= idn; lpos[k] = __hip_atomic_fetch_add(lcnt + sel_e[k], 1u, __ATOMIC_RELAXED, __HIP_MEMORY_SCOPE_WORKGROUP); }
            rstd2[t0 + lane] = rstd;
        }
        __syncthreads();
        if (F.tid < 32) lbase[F.tid] = __hip_atomic_fetch_add(F.ctl + CW_CNT + 64 * F.tid, lcnt[F.tid], RLX_AGENT);
        __syncthreads();
        if (lane < 16) { const int tok = t0 + lane;
#pragma unroll
            for (int k = 0; k < 4; ++k) { const unsigned pos = lbase[sel_e[k]] + lpos[k]; rowtok[(size_t)sel_e[k] * CAP + pos] = (unsigned)tok; tokpos[tok * 4 + k] = ((unsigned)sel_e[k] << 20) | pos; tokgate[tok * 4 + k] = sel_g[k]; } }
        __syncthreads();
    }
}
__device__ __forceinline__ void moe_tables(Frame& F, LAS int* tab) {
    if (F.tid == 0) { int ts = 0, rs = 0;
        for (int e = 0; e < NE; ++e) { const int c = (int)__hip_atomic_load(F.ctl + CW_CNT + 64 * e, RLX_AGENT); tab[e] = ts; tab[40 + e] = c; tab[80 + e] = rs; ts += (c + 255) >> 8; rs += c; }
        tab[32] = ts; tab[112] = rs; }
    __syncthreads();
}
__device__ __forceinline__ void p8_combine(Frame& F, const LAS int* tab) {
    const u32x4* tokpos = (const u32x4*)(F.ws + WS_TOKPOS); const f32x4* tokgate = (const f32x4*)(F.ws + WS_TOKGATE);
    const unsigned char* Y = F.ws + WS_Y; const bf16_t* X1 = (const bf16_t*)(F.ws + WS_X1);
    const int gw = F.bx * NWAVES + F.wave, NGW = F.G * NWAVES, lane = F.lane;
    int t = gw; if (t >= M) return;
    u32x4 tp = tokpos[t]; f32x4 tg = tokgate[t];
    for (; t < M; t += NGW) {
        const int tn = (t + NGW < M) ? t + NGW : t;
        const u32x4 tpn = tokpos[tn]; const f32x4 tgn = tokgate[tn];
        u32x4 yw[4];
#pragma unroll
        for (int k = 0; k < 4; ++k) { const int e = tp[k] >> 20, pos = tp[k] & 0xfffff; const int row = tab[80 + e] + pos; yw[k] = *(const u32x4*)(Y + (size_t)row * D + 16 * lane); }
        const u32x4 xa = *(const u32x4*)(X1 + (size_t)t * D + 16 * lane), xb = *(const u32x4*)(X1 + (size_t)t * D + 16 * lane + 8);
        f32x4 o[4]; pg8::unpack8(xa, o[0], o[1]); pg8::unpack8(xb, o[2], o[3]);
#pragma unroll
        for (int k = 0; k < 4; ++k) { const float gk = tg[k];
#pragma unroll
            for (int q = 0; q < 4; ++q) { const f32x2 lo = __builtin_amdgcn_cvt_pk_f32_fp8((int)yw[k][q], false), hi = __builtin_amdgcn_cvt_pk_f32_fp8((int)yw[k][q], true);
                o[q][0] += gk * lo[0]; o[q][1] += gk * lo[1]; o[q][2] += gk * hi[0]; o[q][3] += gk * hi[1]; } }
        float* op = F.out + (size_t)t * D + 16 * lane;
#pragma unroll
        for (int q = 0; q < 4; ++q) *(f32x4*)(op + 4 * q) = o[q];
        tp = tpn; tg = tgn;
    }
}

constexpr int N_PHASES = 9;
__global__ void __launch_bounds__(NTHREADS, 2) mk_fwd(Args args) {
    extern __shared__ __attribute__((aligned(16))) unsigned char lds_raw[];
    Frame F;
    F.lds = (LAS unsigned char*)lds_raw; F.MISC = (volatile LAS unsigned*)(F.lds + LDS_MISC);
    F.tid = threadIdx.x; F.lane = F.tid & 63; F.wave = __builtin_amdgcn_readfirstlane(F.tid >> 6); F.G = gridDim.x; F.bx = blockIdx.x;
    F.ws = args.ws; F.ctl = (unsigned*)(args.ws + WS_CTL); F.out = args.out;
    F.x = args.in[0]; F.norm_mix = args.in[1]; F.w_in = args.in[2]; F.conv_w = args.in[3]; F.w_out_conv = args.in[4]; F.q_norm = args.in[5]; F.k_norm = args.in[6]; F.rpb = args.in[7];
    F.w_out_attn = args.in[8]; F.w_o = args.in[9]; F.norm_ffn = args.in[10]; F.w_router = args.in[11]; F.b_router = args.in[12]; F.w_gate = args.in[13]; F.b_gate = args.in[14];
    F.w_up = args.in[15]; F.b_up = args.in[16]; F.w_down = args.in[17]; F.b_down = args.in[18];
    if (F.tid < 64) F.MISC[F.tid] = 0u;
    __syncthreads();
    XcdBarrier bar; bar.bar = F.ctl + CW_BAR; bar.x = 0; bar.st = nullptr;
#if !MK_MULTI
    bar = xcd_barrier_post(F.ctl + CW_BAR, F.MISC + 8);
#define GRID_BAR() xcd_barrier(bar)
#else
#define GRID_BAR() do {} while (0)
#endif
    const int lo = args.ph_lo, hi = args.ph_hi;
#define IN(k) (lo <= (k) && (k) < hi)
#define SEAM(k) do { if (IN(k) && IN((k) + 1)) GRID_BAR(); } while (0)
#define REPS(k) (1 + ((PROBE_REP >> (k)) & 1))
#define REP_BEGIN(k) _Pragma("unroll") for (int rep_ = 0; rep_ < REPS(k); ++rep_) { if (rep_ > 0) GRID_BAR();
#define REP_END }
    bf16_t* Hb = (bf16_t*)F.out; bf16_t* za = (bf16_t*)F.out + (size_t)M * D;
    LAS int* tab = (LAS int*)(F.lds + LDS_TAB);

    if (IN(0)) { REP_BEGIN(0) p0_prologue(F); REP_END SEAM(0); }
    if (IN(1)) {
        pg8::DenseOrder S; S.init(Hb, F.ws + WS_WIN, M, PROJW, D * 2, F.G, F.bx);
        pg8::EpiInProj E{(bf16_t*)(F.ws + WS_U), (bf16_t*)(F.ws + WS_BG), (bf16_t*)(F.ws + WS_Q), (bf16_t*)(F.ws + WS_K), (bf16_t*)(F.ws + WS_V), (bf16_t*)(F.ws + WS_R), (bf16_t*)(F.ws + WS_SB), F.q_norm, F.k_norm};
        REP_BEGIN(1) pg8::gemm_phase<pg8::EpiInProj, pg8::DenseOrder, false, true, false>(F.lds, D * 2, S, E); REP_END
        SEAM(1);
    }
    if (IN(2)) { REP_BEGIN(2) p2_conv(F); p2_attn(F); REP_END SEAM(2); }
    if (IN(3)) {
        pg8::DenseOrder S; S.init(za, F.ws + WS_WCA, M, D, D * 2, F.G, F.bx);
        pg8::EpiMix E{(const bf16_t*)(F.ws + WS_R), (const bf16_t*)(F.ws + WS_SB), (bf16_t*)(F.ws + WS_MIXED)};
        REP_BEGIN(3) pg8::gemm_phase<pg8::EpiMix, pg8::DenseOrder, false, true, false>(F.lds, D * 2, S, E); REP_END
        SEAM(3);
    }
    if (IN(4)) {
        pg8::DenseOrder S; S.init(F.ws + WS_MIXED, F.ws + WS_WO, M, D, D * 2, F.G, F.bx);
        pg8::EpiResid E{F.x, (bf16_t*)(F.ws + WS_X1)};
        REP_BEGIN(4) pg8::gemm_phase<pg8::EpiResid, pg8::DenseOrder, false, true, false>(F.lds, D * 2, S, E); REP_END
        SEAM(4);
    }
    if (IN(5)) { p5_router(F); SEAM(5); }
    if (IN(6)) {
        moe_tables(F, tab);
        const int ntiles = tab[32];
        pg8::MoeOrder S; S.init(F.ws + WS_XB, F.ws + WS_WGU, (const unsigned*)(F.ws + WS_ROWTOK), tab, 0, ntiles, 2 * FF, D, F.G, F.bx, true);
        pg8::EpiSwiglu E{F.b_gate, F.b_up, F.ws + WS_ACT};
        REP_BEGIN(6) pg8::gemm_phase<pg8::EpiSwiglu, pg8::MoeOrder, true, true, true>(F.lds, D, S, E); REP_END
        SEAM(6);
    }
    if (IN(7) || IN(8)) {
        moe_tables(F, tab);
        const int ntiles = tab[32];
        if (IN(7)) {
            pg8::EpiDown E{F.b_down, F.ws + WS_Y};
            pg8::MoeOrder S; S.init(F.ws + WS_ACT, F.ws + WS_WD, nullptr, tab, 0, ntiles, D, FF, F.G, F.bx, false);
            REP_BEGIN(7) pg8::gemm_phase<pg8::EpiDown, pg8::MoeOrder, false, true, true>(F.lds, FF, S, E); REP_END
            SEAM(7);
        }
        if (IN(8)) p8_combine(F, tab);
    }
}

extern "C" void kernel_launch(void* const* d_in, const int* in_sizes, int n_in, void* d_out, int out_size, void* d_ws, size_t ws_size, hipStream_t stream) {
    static int grid = 0;
    if (grid == 0) {
        if (n_in != 19 || out_size != M * D || ws_size < WS_END) { fprintf(stderr, "kernel_launch: unexpected shapes / workspace (%zu < %zu)\n", ws_size, (size_t)WS_END); grid = -1; return; }
        if (hipFuncSetAttribute((const void*)mk_fwd, hipFuncAttributeMaxDynamicSharedMemorySize, LDS_BYTES) != hipSuccess) { fprintf(stderr, "kernel_launch: hipFuncSetAttribute failed\n"); grid = -1; return; }
        int dev = 0, cus = 0, per_cu = 0;
        (void)hipGetDevice(&dev); (void)hipDeviceGetAttribute(&cus, hipDeviceAttributeMultiprocessorCount, dev);
        (void)hipOccupancyMaxActiveBlocksPerMultiprocessor(&per_cu, (const void*)mk_fwd, NTHREADS, LDS_BYTES);
        (void)hipGetLastError();
        grid = cus > 0 ? cus : 256;
    }
    if (grid < 0) return;
    (void)hipMemsetAsync((char*)d_ws + WS_CTL, 0, CTL_ZERO_BYTES, stream);
    Args a{};
    for (int i = 0; i < 19; ++i) a.in[i] = (const float*)d_in[i];
    a.out = (float*)d_out; a.ws = (unsigned char*)d_ws;
#if MK_MULTI
    for (int p = 0; p < N_PHASES; ++p) { a.ph_lo = p; a.ph_hi = p + 1; hipLaunchKernelGGL(mk_fwd, dim3(grid), dim3(NTHREADS), LDS_BYTES, stream, a); }
#else
    a.ph_lo = 0; a.ph_hi = N_PHASES;
    hipLaunchKernelGGL(mk_fwd, dim3(grid), dim3(NTHREADS), LDS_BYTES, stream, a);
#endif
}
```

```cpp
#include <hip/hip_runtime.h>
#include <cstdio>
#include <cstdint>

#ifndef MK_MULTI
#define MK_MULTI 0
#endif

#ifndef PROBE_REP
#define PROBE_REP 0
#endif
#define LAS __attribute__((address_space(3)))
#define GAS __attribute__((address_space(1)))
typedef unsigned short bf16_t;
typedef short bf16x8 __attribute__((ext_vector_type(8)));
typedef short s16x4 __attribute__((ext_vector_type(4)));
typedef float f32x4 __attribute__((ext_vector_type(4)));
typedef float f32x2 __attribute__((ext_vector_type(2)));
typedef unsigned u32x4 __attribute__((ext_vector_type(4)));
typedef unsigned u32x2 __attribute__((ext_vector_type(2)));

constexpr int D = 1024, NB = 8, SEQ = 4096, M = NB * SEQ;
constexpr int CONVW = 512, NH = 8, HD = 64, ATTW = 512, PROJW = 5120;
constexpr int NE = 32, TOPK = 4, FF = 1024, NASG = M * TOPK, CAP = M;
constexpr float NORM_EPS = 1e-6f, LOG2E = 1.4426950408889634f;
constexpr int NTHREADS = 512, NWAVES = 8;

constexpr size_t MiB = 1u << 20;
constexpr size_t WS_CTL = 0, CTL_ZERO_BYTES = 64 * 1024;
constexpr size_t WS_WRH = 1 * MiB, WS_WRL = 1 * MiB + 65536;
constexpr size_t WS_ROWTOK = 2 * MiB;
constexpr size_t WS_TOKPOS = 6 * MiB, WS_TOKGATE = 6 * MiB + 512 * 1024;
constexpr size_t WS_RSTD2 = 7 * MiB;
constexpr size_t WS_WIN = 8 * MiB, WS_WCA = 18 * MiB, WS_WO = 20 * MiB;
constexpr size_t WS_WD = 24 * MiB, WS_WGU = 56 * MiB;
constexpr size_t WS_XB = 120 * MiB;
constexpr size_t WS_ACT = 152 * MiB;
constexpr size_t WS_Y = 281 * MiB;
constexpr size_t WS_X1 = 409 * MiB;
constexpr size_t WS_END = WS_X1 + (size_t)M * D * 2;
static_assert(WS_ACT + (size_t)(NASG + 256) * FF <= WS_Y && WS_Y + (size_t)NASG * D <= WS_X1, "ws map");
constexpr size_t WS_U = 152 * MiB, WS_BG = 184 * MiB, WS_Q = 216 * MiB, WS_K = 248 * MiB, WS_V = 280 * MiB, WS_R = 312 * MiB, WS_SB = 376 * MiB;
constexpr size_t WS_MIXED = 152 * MiB;
constexpr float WSCALE = 64.0f, WINV = 1.0f / 64.0f;
constexpr int CW_TMO = 0, CW_CNT = 64  , CW_BAR = 4096;

constexpr int RING_BYTES = 131072;
constexpr int LDS_X = 132096;
constexpr int LDS_TAB = 148992;
constexpr int LDS_CNT = 149504;
constexpr int LDS_MISC = 149760;
constexpr int LDS_BYTES = 163840;
static_assert(LDS_MISC + 256 <= LDS_BYTES, "lds map");

#define RLX_AGENT __ATOMIC_RELAXED, __HIP_MEMORY_SCOPE_AGENT
#define LDS_WAIT() asm volatile("s_waitcnt lgkmcnt(0)" ::: "memory")
#define VM_WAIT() asm volatile("s_waitcnt vmcnt(0)" ::: "memory")
__device__ __forceinline__ unsigned cvt_pk_bf16(float lo, float hi) { unsigned r; asm volatile("v_cvt_pk_bf16_f32 %0, %1, %2" : "=v"(r) : "v"(lo), "v"(hi)); return r; }
__device__ __forceinline__ float bf_lo(unsigned w) { return __uint_as_float(w << 16); }
__device__ __forceinline__ float bf_hi(unsigned w) { return __uint_as_float(w & 0xffff0000u); }
__device__ __forceinline__ int clampi(int v, int lo, int hi) { return v < lo ? lo : (v > hi ? hi : v); }

#define XB_TMO      128
#define XB_XCNT(j)  (256  + 64 * (j))
#define XB_XSUB(j)  (1280 + 64 * (j))
#define XB_XGEN(j)  (2304 + 64 * (j))
#define XB_TOP      3328
#define XB_TOPGEN   3392
#define XCD_BAR_WORDS 3456
#define XB_SPIN_CAP (1u << 18)
__device__ __forceinline__ unsigned xb_ld(unsigned* p)              { return __hip_atomic_load(p, __ATOMIC_RELAXED, __HIP_MEMORY_SCOPE_AGENT); }
__device__ __forceinline__ unsigned xb_add(unsigned* p, unsigned v) { return __hip_atomic_fetch_add(p, v, __ATOMIC_RELAXED, __HIP_MEMORY_SCOPE_AGENT); }
__device__ __forceinline__ unsigned xb_xcc_id() { return (unsigned)__builtin_amdgcn_s_getreg((3 << 11) | 20) & 0xFu; }
#define XB_SPIN(cond, bar) do { unsigned _sp = 0; while (cond) { __builtin_amdgcn_s_sleep(1); \
    if ((++_sp & 255u) == 0u) { if (xb_ld(&(bar)[XB_TMO])) break; if (_sp > XB_SPIN_CAP) { atomicAdd(&(bar)[XB_TMO], 1u); break; } } } } while (0)
struct XcdBarrier { unsigned* bar; unsigned x; volatile LAS unsigned* st; };
__device__ __forceinline__ XcdBarrier xcd_barrier_post(unsigned* bar, volatile LAS unsigned* st) {
    XcdBarrier b; b.bar = bar; b.x = xb_xcc_id(); b.st = st;
    if (threadIdx.x == 0) (void)xb_add(&bar[XB_XCNT(b.x)], 1u);
    return b;
}
__device__ __forceinline__ void xcd_barrier_complete(unsigned* bar, unsigned x, unsigned& nloc, unsigned& nx) {
    const unsigned G = gridDim.x * gridDim.y * gridDim.z;
    unsigned sum, cnt, mine, sp = 0u;
    for (;;) {
        sum = 0u; cnt = 0u; mine = 0u;
#pragma unroll
        for (unsigned j = 0; j < 16; ++j) { const unsigned c = xb_ld(&bar[XB_XCNT(j)]); sum += c; cnt += (c > 0u) ? 1u : 0u; mine = (j == x) ? c : mine; }
        if (sum == G) break;
        __builtin_amdgcn_s_sleep(1);
        if ((++sp & 255u) == 0u) { if (xb_ld(&bar[XB_TMO])) break; if (sp > XB_SPIN_CAP) { atomicAdd(&bar[XB_TMO], 1u); break; } }
    }
    nloc = mine > 0u ? mine : 1u; nx = cnt > 0u ? cnt : 1u;
}
__device__ __forceinline__ void xcd_barrier(const XcdBarrier& b) {
    asm volatile("s_waitcnt vmcnt(0)" ::: "memory");
    __syncthreads();
    if (threadIdx.x == 0) {
        unsigned* bar = b.bar;
        __builtin_amdgcn_s_waitcnt(0);
        unsigned nloc = b.st[0], nx = b.st[1];
        if (nloc == 0u) { xcd_barrier_complete(bar, b.x, nloc, nx); b.st[0] = nloc; b.st[1] = nx; }
        const unsigned old = xb_add(&bar[XB_XSUB(b.x)], 1u);
        const unsigned gen = old / nloc;
        if (old + 1u == (gen + 1u) * nloc) {
            __builtin_amdgcn_fence(__ATOMIC_RELEASE, "agent");
            asm volatile("s_waitcnt vmcnt(0)" ::: "memory");
            const unsigned og = xb_add(&bar[XB_TOP], 1u);
            const unsigned tg = og / nx;
            if (og + 1u == (tg + 1u) * nx) xb_add(&bar[XB_TOPGEN], 1u);
            else XB_SPIN(xb_ld(&bar[XB_TOPGEN]) == tg, bar);
            __builtin_amdgcn_fence(__ATOMIC_ACQUIRE, "agent");
            xb_add(&bar[XB_XGEN(b.x)], 1u);
            asm volatile("s_waitcnt vmcnt(0)" ::: "memory");
        } else {
            XB_SPIN(xb_ld(&bar[XB_XGEN(b.x)]) == gen, bar);
            __builtin_amdgcn_fence(__ATOMIC_ACQUIRE, "agent");
            asm volatile("s_waitcnt vmcnt(0)" ::: "memory");
        }
    }
    __syncthreads();
}

namespace pg8 {
constexpr int BM = 256, BK = 64, HALF = 128, HTB = HALF * BK * 2, NXCD = 8, WGM = 8;
__host__ __device__ __forceinline__ int lds_byte(int r, int c) { const int st = (r >> 4) * 2 + (c >> 5), rr = r & 15, cc = c & 31, ob = rr * 64 + cc * 2; return st * 1024 + (ob ^ (((ob >> 9) & 1) << 5)); }
__host__ __device__ __forceinline__ void stage_rc(int b, int& R, int& C) { const int st = b / 1024, sb = b % 1024, swz = sb ^ (((sb >> 9) & 1) << 5); R = (st >> 1) * 16 + swz / 64; C = (st & 1) * 32 + (swz % 64) / 2; }
__host__ __device__ __forceinline__ int perm32(int rho) { const int n = rho >> 4, i = rho & 15; return 8 * (i >> 2) + 4 * n + (i & 3); }

struct Unit { int pm, pn, e, nvalid, rowbase, lbase; };

struct DenseOrder {
    const char* A; const char* Bt; int nM, nN, nwg, G, c; size_t tstep;
    __device__ void init(const void* A_, const void* Bt_, int Mr, int N, int KB  , int G_, int c_) { A = (const char*)A_; Bt = (const char*)Bt_; nM = Mr / BM; nN = N / BM; nwg = nM * nN; G = G_; c = c_; tstep = (size_t)BM * KB; }
    __device__ __forceinline__ bool next(int i, Unit& u) const {
        const long L = (long)i * G + c; if (L >= nwg) return false;
        int wgid = (int)L; { const int q = nwg / NXCD, r = nwg % NXCD, xcd = wgid % NXCD, off = wgid / NXCD; wgid = (xcd < r ? xcd * (q + 1) : r * (q + 1) + (xcd - r) * q) + off; }
        const int nig = WGM * nN, gid = wgid / nig, fm = gid * WGM, gsz = (nM - fm) < WGM ? (nM - fm) : WGM;
        u.pm = fm + ((wgid % nig) % gsz); u.pn = (wgid % nig) / gsz; u.e = 0; u.nvalid = BM; u.rowbase = 0; u.lbase = 0; return true;
    }
    __device__ __forceinline__ unsigned a_off(const Unit& u) const { return (unsigned)u.pm * (unsigned)tstep; }
    __device__ __forceinline__ unsigned b_off(const Unit& u) const { return (unsigned)u.pn * (unsigned)tstep; }
    __device__ __forceinline__ unsigned row_tok(const Unit&, int) const { return 0u; }
};

struct MoeOrder {
    const char* A; const char* Bt; const unsigned* rowtok; const LAS int* tab; int tlo, nT, nN, nwg, G, c; size_t tstep, estride, rowbytes; bool gather;
    __device__ void init(const void* A_, const void* Bt_, const unsigned* rowtok_, const LAS int* tab_, int tlo_, int thi_, int N, int KB  , int G_, int c_, bool gather_) {
        A = (const char*)A_; Bt = (const char*)Bt_; rowtok = rowtok_; tab = tab_; tlo = tlo_; nT = thi_ - tlo_; if (nT < 0) nT = 0; nN = N / BM; nwg = nT * nN; G = G_; c = c_;
        tstep = (size_t)BM * KB; estride = (size_t)N * KB; rowbytes = (size_t)KB; gather = gather_; }
    __device__ __forceinline__ bool next(int i, Unit& u) const {
        const long L = (long)i * G + c; if (L >= nwg) return false;
        int wgid = (int)L; { const int q = nwg / NXCD, r = nwg % NXCD, xcd = wgid % NXCD, off = wgid / NXCD; wgid = (xcd < r ? xcd * (q + 1) : r * (q + 1) + (xcd - r) * q) + off; }
        const int nig = WGM * nN, gid = wgid / nig, fm = gid * WGM, gsz = (nT - fm) < WGM ? (nT - fm) : WGM;
        const int gt = tlo + fm + ((wgid % nig) % gsz), pn = (wgid % nig) / gsz;
        const int lane = threadIdx.x & 63;
        const int ts = (lane < 32) ? tab[lane] : 0x7fffffff;
        const unsigned long long mask = __ballot(ts <= gt);
        const int e = __builtin_popcountll(mask) - 1;
        const int j = gt - __builtin_amdgcn_readfirstlane(tab[e]);
        const int cnt = __builtin_amdgcn_readfirstlane(tab[40 + e]), es = __builtin_amdgcn_readfirstlane(tab[80 + e]);
        u.pm = gt; u.pn = pn; u.e = e; const int nv = cnt - 256 * j; u.nvalid = nv > 256 ? 256 : nv; u.rowbase = es + 256 * j; u.lbase = e * CAP + 256 * j; return true;
    }
    __device__ __forceinline__ unsigned a_off(const Unit& u) const { return gather ? 0u : (unsigned)u.rowbase * (unsigned)rowbytes; }
    __device__ __forceinline__ unsigned b_off(const Unit& u) const { return (unsigned)u.e * (unsigned)estride + (unsigned)u.pn * (unsigned)tstep; }
    __device__ __forceinline__ unsigned row_tok(const Unit& u, int r) const { const int rr = r < u.nvalid ? r : 0; return rowtok[u.lbase + rr]; }
};

typedef int v8i __attribute__((ext_vector_type(8))); typedef int v4i __attribute__((ext_vector_type(4)));
__device__ __forceinline__ v8i cat8(const bf16x8 a, const bf16x8 b) { return __builtin_shufflevector(__builtin_bit_cast(v4i, a), __builtin_bit_cast(v4i, b), 0, 1, 2, 3, 4, 5, 6, 7); }
template <class Epi, class Sched, bool GATHER, bool ALIGN_EPI, bool FP8, bool NOEPI = false>
__device__ __forceinline__ void gemm_phase(LAS unsigned char* lds, const int KB, const Sched& S, const Epi& E) {
    const int tid = threadIdx.x, wid = __builtin_amdgcn_readfirstlane(tid >> 6), lane = tid & 63, wr = wid >> 2, wc = wid & 3, fr = lane & 15, fq = lane >> 4;
    const int nt = KB / 128;
    int Rst[2], Cst[2]; unsigned voffB[2];
#pragma unroll
    for (int i = 0; i < 2; ++i) { int R, C; stage_rc(tid * 16 + i * 8192, R, C); Rst[i] = R; Cst[i] = C; const int Rb = (R & ~31) + perm32(R & 31); voffB[i] = (unsigned)(Rb * KB + C * 2); }
    const unsigned kstep = 128u;
    const unsigned hstep = (unsigned)HALF * (unsigned)KB;
    const __amdgpu_buffer_rsrc_t rsA = __builtin_amdgcn_make_buffer_rsrc((void*)S.A, 0, 0x7ffffff0, 0x00020000), rsB = __builtin_amdgcn_make_buffer_rsrc((void*)S.Bt, 0, 0x7ffffff0, 0x00020000);
    const unsigned ldsw = (unsigned)wid * 1024u;
    const int aoff = lds_byte(wr * 64 + fr, fq * 8), boff = lds_byte(wc * 32 + fr, fq * 8);
#define PG8_SA(b, h) (((b) * 2 + (h)) * HTB)
#define PG8_SB(b, h) ((4 + (b) * 2 + (h)) * HTB)
#define PG8_GLDS(rs, voff, soff, ldsoff) __builtin_amdgcn_raw_ptr_buffer_load_lds(rs, (LAS unsigned*)(lds + (ldsoff)), 16, (int)(voff), (int)(soff), 0, 0)
#define PG8_STAGE_B(bufoff, soff) do { PG8_GLDS(rsB, voffB[0], soff, (bufoff) + ldsw); PG8_GLDS(rsB, voffB[1], soff, (bufoff) + ldsw + 8192); } while (0)
#define PG8_STAGE_A(bufoff, soff, o0, o1) do { PG8_GLDS(rsA, o0, soff, (bufoff) + ldsw); PG8_GLDS(rsA, o1, soff, (bufoff) + ldsw + 8192); } while (0)
#define PG8_LDA(dst, b, h) do { _Pragma("unroll") for (int m = 0; m < 4; ++m) _Pragma("unroll") for (int k = 0; k < 2; ++k) dst[m][k] = *(const LAS bf16x8*)(lds + PG8_SA(b, h) + aoff + m * 2048 + k * 1024); } while (0)
#define PG8_LDB(dst, b, h) do { _Pragma("unroll") for (int n = 0; n < 2; ++n) _Pragma("unroll") for (int k = 0; k < 2; ++k) dst[n][k] = *(const LAS bf16x8*)(lds + PG8_SB(b, h) + boff + n * 2048 + k * 1024); } while (0)
#define PG8_MMA(ai, bj, At, Bt) do { __builtin_amdgcn_s_setprio(1); _Pragma("unroll") for (int m = 0; m < 4; ++m) _Pragma("unroll") for (int n = 0; n < 2; ++n) { \
        if constexpr (FP8) { const v8i b8_ = cat8(Bt[n][0], Bt[n][1]), a8_ = cat8(At[m][0], At[m][1]); asm volatile("v_mfma_f32_16x16x128_f8f6f4 %0, %1, %2, %0" : "+v"(acc[ai][bj][m][n]) : "v"(b8_), "v"(a8_)); } \
        else { _Pragma("unroll") for (int k = 0; k < 2; ++k) acc[ai][bj][m][n] = __builtin_amdgcn_mfma_f32_16x16x32_bf16(Bt[n][k], At[m][k], acc[ai][bj][m][n], 0, 0, 0); } } \
        __builtin_amdgcn_s_setprio(0); } while (0)
#define PG8_WAIT_V(n) asm volatile("s_waitcnt vmcnt(" #n ")" ::: "memory")
#define PG8_WAIT_L(n) asm volatile("s_waitcnt lgkmcnt(" #n ")" ::: "memory")
#define PG8_BAR __builtin_amdgcn_s_barrier()
#define PG8_SCHED __builtin_amdgcn_sched_barrier(0)
    Unit cur, nxt, nn; int ui = 0;
    if (!S.next(0, cur)) return;
    bool has_next = S.next(1, nxt);
    unsigned coff[2][2], noff[2][2];
#pragma unroll
    for (int h = 0; h < 2; ++h)
#pragma unroll
        for (int i = 0; i < 2; ++i) {
            if constexpr (GATHER) { coff[h][i] = S.row_tok(cur, h * HALF + Rst[i]) * (unsigned)KB + (unsigned)Cst[i] * 2u;
                                    noff[h][i] = has_next ? S.row_tok(nxt, h * HALF + Rst[i]) * (unsigned)KB + (unsigned)Cst[i] * 2u : coff[h][i]; }
            else { coff[h][i] = (unsigned)((h * HALF + Rst[i]) * KB + Cst[i] * 2); noff[h][i] = coff[h][i]; }
        }
    f32x4 acc[2][2][4][2];
#pragma unroll
    for (int a = 0; a < 2; ++a)
#pragma unroll
        for (int b = 0; b < 2; ++b)
#pragma unroll
            for (int m = 0; m < 4; ++m)
#pragma unroll
                for (int n = 0; n < 2; ++n) acc[a][b][m][n] = (f32x4){0.f, 0.f, 0.f, 0.f};
    bf16x8 At[4][2], B0[2][2], B1[2][2];
    unsigned cA = S.a_off(cur), cB = S.b_off(cur);
    PG8_STAGE_B(PG8_SB(0, 0), cB); PG8_STAGE_B(PG8_SB(0, 1), cB + hstep); PG8_STAGE_A(PG8_SA(0, 0), cA, coff[0][0], coff[0][1]); PG8_STAGE_A(PG8_SA(0, 1), cA, coff[1][0], coff[1][1]);
    if (wr == 1) PG8_BAR;
    PG8_WAIT_V(2); PG8_BAR;
    PG8_STAGE_B(PG8_SB(1, 0), cB + kstep); PG8_STAGE_A(PG8_SA(1, 0), cA + kstep, coff[0][0], coff[0][1]); PG8_STAGE_B(PG8_SB(1, 1), cB + hstep + kstep);
    PG8_WAIT_V(6); PG8_BAR;
    for (;;) {
        if constexpr (!GATHER) { if (ui > 0) has_next = S.next(ui + 1, nxt); }
        const unsigned nA = has_next ? S.a_off(nxt) : cA, nB = has_next ? S.b_off(nxt) : cB;
#pragma unroll 1
        for (int t = 0; t < nt; t += 2) {
            const bool last = (t == nt - 2);
            if constexpr (Epi::HAS_MID) { if (t == nt / 2) E.mid(acc, cur, wr, wc, fr, fq); }
            const unsigned a1 = cA + (unsigned)(t + 1) * kstep;
            const unsigned a2 = last ? nA : cA + (unsigned)(t + 2) * kstep, b2 = last ? nB : cB + (unsigned)(t + 2) * kstep;
            const unsigned a3 = a2 + kstep, b3 = b2 + kstep;
            unsigned x00, x01, x10, x11;
            if constexpr (GATHER) { x00 = last ? noff[0][0] : coff[0][0]; x01 = last ? noff[0][1] : coff[0][1]; x10 = last ? noff[1][0] : coff[1][0]; x11 = last ? noff[1][1] : coff[1][1]; }
            else { x00 = coff[0][0]; x01 = coff[0][1]; x10 = coff[1][0]; x11 = coff[1][1]; }
            PG8_LDB(B0, 0, 0); PG8_LDB(B1, 0, 1); PG8_SCHED; PG8_LDA(At, 0, 0); PG8_STAGE_A(PG8_SA(1, 1), a1, coff[1][0], coff[1][1]);
            PG8_WAIT_V(8); PG8_WAIT_L(0); PG8_BAR; PG8_MMA(0, 0, At, B0); PG8_MMA(0, 1, At, B1); PG8_BAR; PG8_SCHED;
            PG8_LDA(At, 0, 1); PG8_STAGE_B(PG8_SB(0, 0), b2); PG8_STAGE_B(PG8_SB(0, 1), b2 + hstep); PG8_STAGE_A(PG8_SA(0, 0), a2, x00, x01);
            PG8_WAIT_V(8); PG8_WAIT_L(0); PG8_BAR; PG8_MMA(1, 0, At, B0); PG8_MMA(1, 1, At, B1); PG8_BAR; PG8_SCHED;
            PG8_LDB(B0, 1, 0); PG8_LDB(B1, 1, 1); PG8_SCHED; PG8_LDA(At, 1, 0); PG8_STAGE_A(PG8_SA(0, 1), a2, x10, x11);
            PG8_WAIT_V(8); PG8_WAIT_L(0); PG8_BAR; PG8_MMA(0, 0, At, B0); PG8_MMA(0, 1, At, B1); PG8_BAR; PG8_SCHED;
            PG8_LDA(At, 1, 1); PG8_STAGE_B(PG8_SB(1, 0), b3); PG8_STAGE_B(PG8_SB(1, 1), b3 + hstep); PG8_STAGE_A(PG8_SA(1, 0), a3, x00, x01);
            PG8_WAIT_V(8); PG8_WAIT_L(0); PG8_BAR; PG8_MMA(1, 0, At, B0); PG8_MMA(1, 1, At, B1); PG8_BAR; PG8_SCHED;
        }
        if constexpr (FP8) asm volatile("s_nop 15\n\ts_nop 15" ::: "memory");
        if constexpr (ALIGN_EPI) { if (wr == 0) PG8_BAR; }
        bool has_nn = false; unsigned pend[2][2] = {{0u, 0u}, {0u, 0u}};
        if constexpr (GATHER) {
            has_nn = has_next && S.next(ui + 2, nn);
            if (has_nn) {
#pragma unroll
                for (int h = 0; h < 2; ++h)
#pragma unroll
                    for (int i = 0; i < 2; ++i) pend[h][i] = S.row_tok(nn, h * HALF + Rst[i]); }
        }
        if constexpr (NOEPI) {
#pragma unroll
            for (int a = 0; a < 2; ++a)
#pragma unroll
                for (int b = 0; b < 2; ++b)
#pragma unroll
                    for (int m = 0; m < 4; ++m) asm volatile("" :: "v"(acc[a][b][m][0]), "v"(acc[a][b][m][1]));
        } else E(acc, cur, wr, wc, fr, fq);
        if (!has_next) break;
#pragma unroll
        for (int a = 0; a < 2; ++a)
#pragma unroll
            for (int b = 0; b < 2; ++b)
#pragma unroll
                for (int m = 0; m < 4; ++m)
#pragma unroll
                    for (int n = 0; n < 2; ++n) acc[a][b][m][n] = (f32x4){0.f, 0.f, 0.f, 0.f};
        cur = nxt; cA = nA; cB = nB; ++ui;
        if constexpr (GATHER) {
#pragma unroll
            for (int h = 0; h < 2; ++h)
#pragma unroll
                for (int i = 0; i < 2; ++i) { coff[h][i] = noff[h][i]; if (has_nn) noff[h][i] = pend[h][i] * (unsigned)KB + (unsigned)Cst[i] * 2u; }
            nxt = nn; has_next = has_nn;
        }
        if constexpr (ALIGN_EPI) { if (wr == 1) PG8_BAR; }
    }
    PG8_WAIT_V(0);
    if constexpr (!ALIGN_EPI) { if (wr == 0) PG8_BAR; }
    PG8_BAR;
#undef PG8_SA
#undef PG8_SB
#undef PG8_GLDS
#undef PG8_STAGE_A
#undef PG8_STAGE_B
#undef PG8_LDA
#undef PG8_LDB
#undef PG8_MMA
#undef PG8_WAIT_V
#undef PG8_WAIT_L
#undef PG8_BAR
#undef PG8_SCHED
}

typedef f32x4 Acc[2][2][4][2];
#ifndef EPI_NT
#define EPI_NT 0
#endif
#if EPI_NT
#define NT_STORE(T, p, v) __builtin_nontemporal_store((T)(v), (T*)(p))
#else
#define NT_STORE(T, p, v) (*(T*)(p) = (v))
#endif
__device__ __forceinline__ u32x4 pack8(const f32x4 a, const f32x4 b) { u32x4 w; w.x = cvt_pk_bf16(a[0], a[1]); w.y = cvt_pk_bf16(a[2], a[3]); w.z = cvt_pk_bf16(b[0], b[1]); w.w = cvt_pk_bf16(b[2], b[3]); return w; }
__device__ __forceinline__ unsigned pk_fp8x4(float a, float b, float c, float d) { int w = __builtin_amdgcn_cvt_pk_fp8_f32(a, b, 0, false); w = __builtin_amdgcn_cvt_pk_fp8_f32(c, d, w, true); return (unsigned)w; }
__device__ __forceinline__ u32x2 pack8_fp8(const f32x4 a, const f32x4 b) { u32x2 w; w.x = pk_fp8x4(a[0], a[1], a[2], a[3]); w.y = pk_fp8x4(b[0], b[1], b[2], b[3]); return w; }
__device__ __forceinline__ void unpack8(const u32x4 w, f32x4& a, f32x4& b) { a = (f32x4){bf_lo(w.x), bf_hi(w.x), bf_lo(w.y), bf_hi(w.y)}; b = (f32x4){bf_lo(w.z), bf_hi(w.z), bf_lo(w.w), bf_hi(w.w)}; }

struct EpiInProj {
    static constexpr bool HAS_MID = false;
    bf16_t *U, *Bg, *Q, *Kk, *V, *R, *SB; const float *qn, *kn;
    __device__ __forceinline__ void operator()(const Acc& acc, const Unit& u, int wr, int wc, int fr, int fq) const {
        const int t = u.pn; const size_t row0 = (size_t)u.pm * BM + wr * 64 + fr; const int cb = wc * 32 + 8 * fq;
        if (t < 4) {
#pragma unroll
            for (int ai = 0; ai < 2; ++ai)
#pragma unroll
                for (int m = 0; m < 4; ++m) { const size_t r = row0 + ai * HALF + m * 16;
                    NT_STORE(u32x4, (U + r * CONVW + t * 128 + cb), (pack8(acc[ai][0][m][0] * acc[ai][1][m][0], acc[ai][0][m][1] * acc[ai][1][m][1]))); }
        } else if (t < 6 || t == 10 || t == 11) {
            bf16_t* base = (t < 6) ? Bg + (t - 4) * 256 : V + (t - 10) * 256;
#pragma unroll
            for (int ai = 0; ai < 2; ++ai)
#pragma unroll
                for (int m = 0; m < 4; ++m) { const size_t r = row0 + ai * HALF + m * 16;
#pragma unroll
                    for (int bj = 0; bj < 2; ++bj) NT_STORE(u32x4, (base + r * 512 + bj * HALF + cb), (pack8(acc[ai][bj][m][0], acc[ai][bj][m][1]))); }
        } else if (t < 10) {
            const bool isq = t < 8; bf16_t* base = isq ? Q : Kk; const float* gn = isq ? qn : kn; const float sc = isq ? 0.125f * LOG2E : 1.0f;
            const int hh = 4 * (t & 1) + wc;
            f32x4 g[2][2];
#pragma unroll
            for (int bj = 0; bj < 2; ++bj) { g[bj][0] = *(const f32x4*)(gn + 32 * bj + 8 * fq) * sc; g[bj][1] = *(const f32x4*)(gn + 32 * bj + 8 * fq + 4) * sc; }
#pragma unroll
            for (int ai = 0; ai < 2; ++ai)
#pragma unroll
                for (int m = 0; m < 4; ++m) { const size_t r = row0 + ai * HALF + m * 16; float ss = 0.f;
#pragma unroll
                    for (int bj = 0; bj < 2; ++bj)
#pragma unroll
                        for (int n = 0; n < 2; ++n) { const f32x4 v = acc[ai][bj][m][n]; ss += (v[0] * v[0] + v[1] * v[1]) + (v[2] * v[2] + v[3] * v[3]); }
                    ss += __shfl_xor(ss, 16); ss += __shfl_xor(ss, 32);
                    const float rinv = __builtin_amdgcn_rsqf(ss * (1.0f / 64.0f) + NORM_EPS);
#pragma unroll
                    for (int bj = 0; bj < 2; ++bj) NT_STORE(u32x4, (base + r * 512 + hh * 64 + 32 * bj + 8 * fq), (pack8(acc[ai][bj][m][0] * rinv * g[bj][0], acc[ai][bj][m][1] * rinv * g[bj][1]))); }
        } else {
            const int gi = t - 12;
#pragma unroll
            for (int ai = 0; ai < 2; ++ai)
#pragma unroll
                for (int m = 0; m < 4; ++m) { const size_t r = row0 + ai * HALF + m * 16; f32x4 rr[2], sb[2];
#pragma unroll
                    for (int n = 0; n < 2; ++n)
#pragma unroll
                        for (int j = 0; j < 4; ++j) { float a = acc[ai][0][m][n][j], b = acc[ai][1][m][n][j];
                            a = fminf(fmaxf(a, -30.f), 30.f); b = fminf(fmaxf(b, -30.f), 30.f);
                            const float ea = __builtin_amdgcn_exp2f(-a * LOG2E), eb = __builtin_amdgcn_exp2f(-b * LOG2E);
                            const float ia = __builtin_amdgcn_rcpf(1.f + ea), ib = __builtin_amdgcn_rcpf(1.f + eb);
                            rr[n][j] = (1.f + eb) * ia; sb[n][j] = ib; }
                    NT_STORE(u32x4, (R + r * D + gi * 128 + cb), (pack8(rr[0], rr[1]))); NT_STORE(u32x4, (SB + r * D + gi * 128 + cb), (pack8(sb[0], sb[1]))); }
        }
    }
};
struct EpiMix {
    static constexpr bool HAS_MID = true;
    const bf16_t *R, *SB; bf16_t* O;
    __device__ __forceinline__ void mid(Acc& acc, const Unit& u, int wr, int wc, int fr, int fq) const {
        const size_t row0 = (size_t)u.pm * BM + wr * 64 + fr; const int col0 = u.pn * BM + wc * 32 + 8 * fq;
#pragma unroll
        for (int ai = 0; ai < 2; ++ai)
#pragma unroll
            for (int m = 0; m < 4; ++m) { const size_t r = row0 + ai * HALF + m * 16;
#pragma unroll
                for (int bj = 0; bj < 2; ++bj) { f32x4 a, b; unpack8(*(const u32x4*)(R + r * D + col0 + bj * HALF), a, b); acc[ai][bj][m][0] *= a; acc[ai][bj][m][1] *= b; } }
    }
    __device__ __forceinline__ void operator()(const Acc& acc, const Unit& u, int wr, int wc, int fr, int fq) const {
        const size_t row0 = (size_t)u.pm * BM + wr * 64 + fr; const int col0 = u.pn * BM + wc * 32 + 8 * fq;
#pragma unroll
        for (int ai = 0; ai < 2; ++ai)
#pragma unroll
            for (int m = 0; m < 4; ++m) { const size_t r = row0 + ai * HALF + m * 16;
#pragma unroll
                for (int bj = 0; bj < 2; ++bj) { f32x4 a, b; unpack8(*(const u32x4*)(SB + r * D + col0 + bj * HALF), a, b);
                    NT_STORE(u32x4, (O + r * D + col0 + bj * HALF), (pack8(acc[ai][bj][m][0] * a, acc[ai][bj][m][1] * b))); } }
    }
};
struct EpiResid {
    static constexpr bool HAS_MID = false;
    const float* X; bf16_t* O;
    __device__ __forceinline__ void operator()(const Acc& acc, const Unit& u, int wr, int wc, int fr, int fq) const {
        const size_t row0 = (size_t)u.pm * BM + wr * 64 + fr; const int col0 = u.pn * BM + wc * 32 + 8 * fq;
#pragma unroll
        for (int ai = 0; ai < 2; ++ai)
#pragma unroll
            for (int m = 0; m < 4; ++m) { const size_t r = row0 + ai * HALF + m * 16;
#pragma unroll
                for (int bj = 0; bj < 2; ++bj) { const size_t o = r * D + col0 + bj * HALF;
                    const f32x4 v0 = *(const f32x4*)(X + o) + acc[ai][bj][m][0], v1 = *(const f32x4*)(X + o + 4) + acc[ai][bj][m][1];
                    NT_STORE(u32x4, (O + o), (pack8(v0, v1))); } }
    }
};
struct EpiSwiglu {
    static constexpr bool HAS_MID = false;
    const float *bg, *bu; unsigned char* act;
    __device__ __forceinline__ void operator()(const Acc& acc, const Unit& u, int wr, int wc, int fr, int fq) const {
        asm volatile("" : "+v"(fr), "+v"(fq));
        const int f0 = u.pn * 128 + wc * 32 + 8 * fq;
        f32x4 g0 = *(const f32x4*)(bg + u.e * FF + f0), g1 = *(const f32x4*)(bg + u.e * FF + f0 + 4), u0 = *(const f32x4*)(bu + u.e * FF + f0), u1 = *(const f32x4*)(bu + u.e * FF + f0 + 4);
#pragma unroll
        for (int ai = 0; ai < 2; ++ai)
#pragma unroll
            for (int m = 0; m < 4; ++m) { const int rl = ai * HALF + wr * 64 + m * 16 + fr;
                if (rl < u.nvalid) {
                    const float rs = WINV;
                    f32x4 o[2];
#pragma unroll
                    for (int n = 0; n < 2; ++n)
#pragma unroll
                        for (int j = 0; j < 4; ++j) { const float gb = n ? g1[j] : g0[j], ub = n ? u1[j] : u0[j];
                            float g = fminf(acc[ai][0][m][n][j] * rs + gb, 7.0f); float uu = fminf(fmaxf(acc[ai][1][m][n][j] * rs + ub, -7.0f), 7.0f);
                            const float sg = __builtin_amdgcn_rcpf(1.f + __builtin_amdgcn_exp2f(-1.702f * LOG2E * g));
                            o[n][j] = g * sg * (uu + 1.0f); }
                    NT_STORE(u32x2, (act + (size_t)(u.rowbase + rl) * FF + f0), (pack8_fp8(o[0], o[1]))); } }
        asm volatile("" :: "v"(g0), "v"(g1), "v"(u0), "v"(u1));
    }
};
struct EpiDown {
    static constexpr bool HAS_MID = false;
    const float* bd; unsigned char* Y;
    __device__ __forceinline__ void operator()(const Acc& acc, const Unit& u, int wr, int wc, int fr, int fq) const {
        asm volatile("" : "+v"(fr), "+v"(fq));
        const int col0 = u.pn * BM + wc * 32 + 8 * fq;
        unsigned char* yb = Y + (size_t)u.rowbase * D;
        f32x4 b[2][2];
#pragma unroll
        for (int bj = 0; bj < 2; ++bj) { b[bj][0] = *(const f32x4*)(bd + u.e * D + col0 + bj * HALF); b[bj][1] = *(const f32x4*)(bd + u.e * D + col0 + bj * HALF + 4); }
#pragma unroll
        for (int ai = 0; ai < 2; ++ai)
#pragma unroll
            for (int m = 0; m < 4; ++m) { const int rl = ai * HALF + wr * 64 + m * 16 + fr;
                if (rl < u.nvalid) {
#pragma unroll
                    for (int bj = 0; bj < 2; ++bj) NT_STORE(u32x2, (yb + (size_t)rl * D + col0 + bj * HALF), (pack8_fp8(acc[ai][bj][m][0] * WINV + b[bj][0], acc[ai][bj][m][1] * WINV + b[bj][1]))); } }
        asm volatile("" :: "v"(b[0][0]), "v"(b[0][1]), "v"(b[1][0]), "v"(b[1][1]));
    }
};
}

struct Args { const float* in[19]; float* out; unsigned char* ws; int ph_lo, ph_hi; };
struct Frame {
    LAS unsigned char* lds; volatile LAS unsigned* MISC; unsigned* ctl;
    int tid, lane, wave, G, bx;
    const float *x, *norm_mix, *w_in, *conv_w, *w_out_conv, *q_norm, *k_norm, *rpb, *w_out_attn, *w_o, *norm_ffn, *w_router, *b_router, *w_gate, *b_gate, *w_up, *b_up, *w_down, *b_down;
    float* out; unsigned char* ws;
};

__device__ __forceinline__ float wave_sum(float v) {
#pragma unroll
    for (int o = 1; o < 64; o <<= 1) v += __shfl_xor(v, o);
    return v;
}

__device__ __forceinline__ s16x4 tr_read(const LAS unsigned char* p) { return __builtin_bit_cast(s16x4, __builtin_amdgcn_ds_read_tr16_b64_v4i16((LAS s16x4*)p)); }
using pg8::pk_fp8x4;
__device__ __forceinline__ float bf2f(short h) { return __uint_as_float(((unsigned)(unsigned short)h) << 16); }
template <bool FP8>
__device__ __forceinline__ void p0_item(const float* W, int ldw, int k0, int c0a, int c0b  , unsigned char* dst  , int ldd  , const float* ks, float mul, LAS unsigned char* T, int lane) {
    constexpr int RS = 144;
    const int lq = lane >> 4, li = lane & 15, c0 = (li < 8 ? c0a : c0b) + 4 * (li & 7);
    f32x4 v[16];
#pragma unroll
    for (int i = 0; i < 16; ++i) v[i] = *(const f32x4*)(W + (size_t)(k0 + 4 * i + lq) * ldw + c0);
#pragma unroll
    for (int i = 0; i < 16; ++i) { const int k = 4 * i + lq; const float sc = ks ? mul * ks[k0 + k] : mul; const f32x4 y = v[i] * sc;
        u32x2 w; w.x = cvt_pk_bf16(y[0], y[1]); w.y = cvt_pk_bf16(y[2], y[3]); *(LAS u32x2*)(T + k * RS + 8 * li) = w; }
    LDS_WAIT(); asm volatile("" ::: "memory");
    const LAS unsigned char* tb = T + (li >> 2) * RS + (li & 3) * 8;
#pragma unroll
    for (int nb = 0; nb < 4; ++nb) {
        if constexpr (FP8) {
            s16x4 t[4];
#pragma unroll
            for (int j = 0; j < 4; ++j) t[j] = tr_read(tb + (16 * lq + 4 * j) * RS + nb * 32);
            u32x4 o;
            o.x = pk_fp8x4(bf2f(t[0][0]), bf2f(t[0][1]), bf2f(t[0][2]), bf2f(t[0][3])); o.y = pk_fp8x4(bf2f(t[1][0]), bf2f(t[1][1]), bf2f(t[1][2]), bf2f(t[1][3]));
            o.z = pk_fp8x4(bf2f(t[2][0]), bf2f(t[2][1]), bf2f(t[2][2]), bf2f(t[2][3])); o.w = pk_fp8x4(bf2f(t[3][0]), bf2f(t[3][1]), bf2f(t[3][2]), bf2f(t[3][3]));
            *(u32x4*)(dst + (size_t)(16 * nb + li) * ldd + 16 * lq) = o;
        } else {
#pragma unroll
            for (int hf = 0; hf < 2; ++hf) { const int c = lq + 4 * hf;
                const s16x4 lo = tr_read(tb + (8 * c) * RS + nb * 32), hi = tr_read(tb + (8 * c + 4) * RS + nb * 32);
                const bf16x8 o = {lo[0], lo[1], lo[2], lo[3], hi[0], hi[1], hi[2], hi[3]};
                *(bf16x8*)(dst + (size_t)(16 * nb + li) * ldd + 16 * c) = o; }
        }
    }
    LDS_WAIT(); asm volatile("" ::: "memory");
}
__device__ __forceinline__ int inproj_srccol(int n0) {
    const int t = n0 >> 8, bj = (n0 >> 7) & 1, w = (n0 >> 5) & 3;
    if (t < 4) return (bj ? 1024 : 0) + 128 * t + 32 * w;
    if (t < 6) return 512 + 256 * (t - 4) + 128 * bj + 32 * w;
    if (t < 8) return 1536 + (4 * (t - 6) + w) * 64 + 32 * bj;
    if (t < 10) return 2048 + (4 * (t - 8) + w) * 64 + 32 * bj;
    if (t < 12) return 2560 + 256 * (t - 10) + 128 * bj + 32 * w;
    return (bj ? 4096 : 3072) + 128 * (t - 12) + 32 * w;
}
__device__ __forceinline__ void p0_prologue(Frame& F) {
    LAS unsigned char* T = F.lds + F.wave * 9216;
    const int gw = F.bx * NWAVES + F.wave, NGW = F.G * NWAVES, lane = F.lane;
    unsigned char* Win = F.ws + WS_WIN; unsigned char* Wca = F.ws + WS_WCA; unsigned char* Wo = F.ws + WS_WO; unsigned char* Wd = F.ws + WS_WD; unsigned char* Wgu = F.ws + WS_WGU;
    constexpr int I_IN = 16 * 80, I_CA = 2 * 8 * 16, I_O = 16 * 16, I_GU = NE * 16 * 32, I_D = NE * 16 * 16;
    constexpr int NITEMS = I_IN + I_CA + I_O + I_GU + I_D;
    for (int it = gw; it < NITEMS; it += NGW) {
        int r = it;
        if (r < I_IN) { const int kb = r / 80, nb = r % 80; p0_item<false>(F.w_in, PROJW, 64 * kb, inproj_srccol(64 * nb), inproj_srccol(64 * nb + 32), Win + ((size_t)(64 * nb) * D + 64 * kb) * 2, D * 2, nullptr, 1.f, T, lane); continue; } r -= I_IN;
        if (r < I_CA) { const int s = r / 128, q = r % 128, kb = q / 16, nb = q % 16; p0_item<false>(s ? F.w_out_attn : F.w_out_conv, D, 64 * kb, 64 * nb, 64 * nb + 32, Wca + ((size_t)(64 * nb) * D + 512 * s + 64 * kb) * 2, D * 2, nullptr, 1.f, T, lane); continue; } r -= I_CA;
        if (r < I_O) { const int kb = r / 16, nb = r % 16; p0_item<false>(F.w_o, D, 64 * kb, 64 * nb, 64 * nb + 32, Wo + ((size_t)(64 * nb) * D + 64 * kb) * 2, D * 2, nullptr, 1.f, T, lane); continue; } r -= I_O;
        if (r < I_GU) { const int e = r / 512, q = r % 512, kb = q / 32, nb = q % 32, n0 = 64 * nb, pn = n0 >> 8, bj = (n0 >> 7) & 1, c64 = n0 & 127;
            p0_item<true>((bj ? F.w_up : F.w_gate) + (size_t)e * D * FF, FF, 64 * kb, 128 * pn + c64, 128 * pn + c64 + 32, Wgu + ((size_t)e * 2048 + n0) * D + 64 * kb, D, F.norm_ffn, WSCALE, T, lane); continue; } r -= I_GU;
        { const int e = r / 256, q = r % 256, kb = q / 16, nb = q % 16; p0_item<true>(F.w_down + (size_t)e * FF * D, D, 64 * kb, 64 * nb, 64 * nb + 32, Wd + ((size_t)e * D + 64 * nb) * FF + 64 * kb, FF, nullptr, WSCALE, T, lane); }
    }
    { bf16_t* wh = (bf16_t*)(F.ws + WS_WRH); bf16_t* wl = (bf16_t*)(F.ws + WS_WRL);
      for (int i = F.bx * NTHREADS + F.tid; i < NE * D; i += F.G * NTHREADS) { const int e = i >> 10, k = i & 1023; const float v = F.w_router[k * NE + e] * F.norm_ffn[k];
          const unsigned h = cvt_pk_bf16(v, 0.f) & 0xffffu; const float lo = v - __uint_as_float(h << 16); wh[i] = (bf16_t)h; wl[i] = (bf16_t)(cvt_pk_bf16(lo, 0.f) & 0xffffu); } }
    bf16_t* Hb = (bf16_t*)F.out;
    for (int m = gw; m < M; m += NGW) {
        const f32x4* xr = (const f32x4*)(F.x + (size_t)m * D) + lane; f32x4 v[4]; float s = 0.f;
#pragma unroll
        for (int j = 0; j < 4; ++j) { v[j] = xr[64 * j]; s += (v[j][0] * v[j][0] + v[j][1] * v[j][1]) + (v[j][2] * v[j][2] + v[j][3] * v[j][3]); }
        const float rstd = 1.0f / sqrtf(wave_sum(s) * (1.f / D) + NORM_EPS);
        unsigned long long* o8 = (unsigned long long*)(Hb + (size_t)m * D) + lane;
#pragma unroll
        for (int j = 0; j < 4; ++j) { const f32x4 g = *((const f32x4*)F.norm_mix + lane + 64 * j); const f32x4 y = v[j] * rstd * g;
            o8[64 * j] = (unsigned long long)cvt_pk_bf16(y[0], y[1]) | ((unsigned long long)cvt_pk_bf16(y[2], y[3]) << 32); }
    }
}

__device__ __forceinline__ void p2_conv(Frame& F) {
    const bf16_t* U = (const bf16_t*)(F.ws + WS_U); const bf16_t* Bg = (const bf16_t*)(F.ws + WS_BG); bf16_t* za = (bf16_t*)F.out + (size_t)M * D;
    const int c8 = (F.tid & 63) * 8;
    const f32x4 w00 = *(const f32x4*)(F.conv_w + c8), w01 = *(const f32x4*)(F.conv_w + c8 + 4), w10 = *(const f32x4*)(F.conv_w + CONVW + c8), w11 = *(const f32x4*)(F.conv_w + CONVW + c8 + 4),
                w20 = *(const f32x4*)(F.conv_w + 2 * CONVW + c8), w21 = *(const f32x4*)(F.conv_w + 2 * CONVW + c8 + 4);
    const int stride = F.G * NTHREADS;
    for (int it0 = F.bx * NTHREADS + F.tid; it0 < M * 64; it0 += 4 * stride) {
        u32x4 u0[4], um[4], up[4], bb[4];
#pragma unroll
        for (int j = 0; j < 4; ++j) { const int it = it0 + j * stride; const bool ok = it < M * 64; const int t = ok ? it >> 6 : 0, sq = t & (SEQ - 1);
            const u32x4 z4 = {0u, 0u, 0u, 0u};
            u0[j] = *(const u32x4*)(U + (size_t)t * CONVW + c8); um[j] = sq > 0 ? *(const u32x4*)(U + (size_t)(t - 1) * CONVW + c8) : z4; up[j] = sq < SEQ - 1 ? *(const u32x4*)(U + (size_t)(t + 1) * CONVW + c8) : z4;
            bb[j] = *(const u32x4*)(Bg + (size_t)t * CONVW + c8); }
#pragma unroll
        for (int j = 0; j < 4; ++j) { const int it = it0 + j * stride; if (it < M * 64) { const int t = it >> 6;
            f32x4 a0, a1, m0, m1, p0, p1, b0, b1; pg8::unpack8(u0[j], a0, a1); pg8::unpack8(um[j], m0, m1); pg8::unpack8(up[j], p0, p1); pg8::unpack8(bb[j], b0, b1);
            const f32x4 z0 = b0 * (w00 * m0 + w10 * a0 + w20 * p0), z1 = b1 * (w01 * m1 + w11 * a1 + w21 * p1);
            *(u32x4*)(za + (size_t)t * D + c8) = pg8::pack8(z0, z1); } }
    }
}
__device__ __forceinline__ void p2_attn(Frame& F) {
    const bf16_t* Q = (const bf16_t*)(F.ws + WS_Q); const bf16_t* Kp = (const bf16_t*)(F.ws + WS_K); const bf16_t* V = (const bf16_t*)(F.ws + WS_V);
    bf16_t* za = (bf16_t*)F.out + (size_t)M * D;
    LAS unsigned char* Ks = F.lds; LAS unsigned char* Vs = F.lds + 65536; LAS float* rpbl = (LAS float*)(F.lds + LDS_X);
    for (int i = F.tid; i < NH * 15 * 31; i += NTHREADS) rpbl[i] = F.rpb[i] * LOG2E;
    const int lane = F.lane, g = lane >> 4, l15 = lane & 15;
    constexpr int NU = NB * NH * 32;
    u32x4 kv[8], vv[8]; bf16x8 qn[2];
#define ATT_LOAD(UN) do { const int cb_ = (UN) & 3, rb_ = ((UN) >> 2) & 7, h_ = ((UN) >> 5) & 7, b_ = (UN) >> 8; const int kr_ = clampi(8 * rb_ - 4, 0, 48), kc_ = clampi(16 * cb_ - 8, 0, 32); \
        _Pragma("unroll") for (int i = 0; i < 8; ++i) { const int cid = F.tid + NTHREADS * i, key = cid >> 3, c = cid & 7; const size_t tok = (size_t)b_ * SEQ + (kr_ + (key >> 5)) * 64 + kc_ + (key & 31); \
            kv[i] = *(const u32x4*)(Kp + tok * ATTW + h_ * HD + c * 8); vv[i] = *(const u32x4*)(V + tok * ATTW + h_ * HD + c * 8); } \
        { const size_t qt_ = (size_t)b_ * SEQ + (8 * rb_ + F.wave) * 64 + 16 * cb_ + l15; qn[0] = *(const bf16x8*)(Q + qt_ * ATTW + h_ * HD + 8 * g); qn[1] = *(const bf16x8*)(Q + qt_ * ATTW + h_ * HD + 32 + 8 * g); } } while (0)
    if (F.bx < NU) ATT_LOAD(F.bx);
    for (int un = F.bx; un < NU; un += F.G) {
        const int cbk = un & 3, rb = (un >> 2) & 7, h = (un >> 5) & 7, b = un >> 8;
        const int kr0 = clampi(8 * rb - 4, 0, 48), kc0 = clampi(16 * cbk - 8, 0, 32);
        __syncthreads();
#pragma unroll
        for (int i = 0; i < 8; ++i) { const int cid = F.tid + NTHREADS * i, key = cid >> 3, c = cid & 7;
            *(LAS u32x4*)(Ks + key * 128 + ((c ^ ((key >> 1) & 7)) << 4)) = kv[i]; *(LAS u32x4*)(Vs + key * 128 + ((c ^ (((key >> 1) & 3) << 1)) << 4)) = vv[i]; }
        __syncthreads();
        const int qr = 8 * rb + F.wave, rs = clampi(qr - 4, 0, 56), krs = rs - kr0, qc = 16 * cbk + l15, cs = clampi(qc - 8, 0, 48);
        const size_t qtok = (size_t)b * SEQ + qr * 64 + qc;
        const bf16x8 qf[2] = {qn[0], qn[1]};
        if (un + F.G < NU) ATT_LOAD(un + F.G);
        f32x4 sc[8][2];
#pragma unroll
        for (int jr = 0; jr < 8; ++jr)
#pragma unroll
            for (int f = 0; f < 2; ++f) { const int key = (krs + jr) * 32 + 16 * f + l15; f32x4 a = {0.f, 0.f, 0.f, 0.f};
#pragma unroll
                for (int ks = 0; ks < 2; ++ks) { const bf16x8 kf = *(const LAS bf16x8*)(Ks + key * 128 + (((4 * ks + g) ^ ((key >> 1) & 7)) << 4)); a = __builtin_amdgcn_mfma_f32_16x16x32_bf16(kf, qf[ks], a, 0, 0, 0); }
                sc[jr][f] = a; }
        float mx = -1e30f;
        const LAS float* ab = rpbl + h * 465 + (rs - qr + 7) * 31 + (kc0 + 4 * g - qc + 15);
        const int kd0 = kc0 + 4 * g - cs;
#pragma unroll
        for (int jr = 0; jr < 8; ++jr)
#pragma unroll
            for (int f = 0; f < 2; ++f)
#pragma unroll
                for (int r = 0; r < 4; ++r) { const bool valid = (unsigned)(kd0 + 16 * f + r) < 16u; const float bias = ab[jr * 31 + 16 * f + r];
                    const float sv = valid ? sc[jr][f][r] + bias : -1e30f; sc[jr][f][r] = sv; mx = fmaxf(mx, sv); }
        mx = fmaxf(mx, __shfl_xor(mx, 16)); mx = fmaxf(mx, __shfl_xor(mx, 32));
        float sum = 0.f;
#pragma unroll
        for (int jr = 0; jr < 8; ++jr)
#pragma unroll
            for (int f = 0; f < 2; ++f)
#pragma unroll
                for (int r = 0; r < 4; ++r) { const float p = __builtin_amdgcn_exp2f(sc[jr][f][r] - mx); sc[jr][f][r] = p; sum += p; }
        sum += __shfl_xor(sum, 16); sum += __shfl_xor(sum, 32);
        f32x4 o[4];
#pragma unroll
        for (int db = 0; db < 4; ++db) o[db] = (f32x4){0.f, 0.f, 0.f, 0.f};
        const int q4 = l15 >> 2, p4 = lane & 3;
#pragma unroll
        for (int jr = 0; jr < 8; ++jr) {
            const u32x4 pw = pg8::pack8(sc[jr][0], sc[jr][1]); const bf16x8 pb = __builtin_bit_cast(bf16x8, pw);
            const int key1 = (krs + jr) * 32 + 4 * g + q4, key2 = key1 + 16;
#pragma unroll
            for (int db = 0; db < 4; ++db) { const int ch = 2 * db + (p4 >> 1);
                const s16x4 lo = tr_read(Vs + key1 * 128 + ((ch ^ (((key1 >> 1) & 3) << 1)) << 4) + 8 * (p4 & 1));
                const s16x4 hi = tr_read(Vs + key2 * 128 + ((ch ^ (((key2 >> 1) & 3) << 1)) << 4) + 8 * (p4 & 1));
                const bf16x8 vf = {lo[0], lo[1], lo[2], lo[3], hi[0], hi[1], hi[2], hi[3]};
                o[db] = __builtin_amdgcn_mfma_f32_16x16x32_bf16(vf, pb, o[db], 0, 0, 0); } }
        const float inv = 1.0f / sum;
#pragma unroll
        for (int db = 0; db < 4; ++db) { const f32x4 v = o[db] * inv; u32x2 w; w.x = cvt_pk_bf16(v[0], v[1]); w.y = cvt_pk_bf16(v[2], v[3]);
            *(u32x2*)(za + qtok * D + 512 + h * HD + 16 * db + 4 * g) = w; }
    }
    __syncthreads();
}

__device__ __forceinline__ void p5_router(Frame& F) {
    constexpr int RS = 2064;
    LAS unsigned char* Th = F.lds; LAS unsigned char* Tl = F.lds + 32 * RS;
    LAS float* lg = (LAS float*)(F.lds + LDS_X + F.wave * 2112);
    LAS unsigned* lcnt = (LAS unsigned*)(F.lds + LDS_CNT); LAS unsigned* lbase = lcnt + 32;
    const bf16_t* wh = (const bf16_t*)(F.ws + WS_WRH); const bf16_t* wl = (const bf16_t*)(F.ws + WS_WRL);
    for (int i = F.tid; i < 32 * 128; i += NTHREADS) { const int e = i >> 7, c = i & 127; *(LAS u32x4*)(Th + e * RS + c * 16) = *(const u32x4*)(wh + e * D + c * 8); *(LAS u32x4*)(Tl + e * RS + c * 16) = *(const u32x4*)(wl + e * D + c * 8); }
    const int lane = F.lane, g = lane >> 4, l15 = lane & 15;
    unsigned* rowtok = (unsigned*)(F.ws + WS_ROWTOK); unsigned* tokpos = (unsigned*)(F.ws + WS_TOKPOS); float* tokgate = (float*)(F.ws + WS_TOKGATE); float* rstd2 = (float*)(F.ws + WS_RSTD2);
    for (int ch = F.bx; ch < M / 128; ch += F.G) {
        if (F.tid < 32) lcnt[F.tid] = 0u;
        __syncthreads();
        const int t0 = ch * 128 + F.wave * 16;
        f32x4 a0 = {0.f, 0.f, 0.f, 0.f}, a1 = {0.f, 0.f, 0.f, 0.f}; float ssq = 0.f;
        const bf16_t* xp = (const bf16_t*)(F.ws + WS_X1) + (size_t)(t0 + l15) * D + 8 * g;
#pragma unroll 8
        for (int s = 0; s < 32; ++s) {
            const u32x4 xw = *(const u32x4*)(xp + 32 * s); f32x4 v0, v1; pg8::unpack8(xw, v0, v1);
            ssq += (v0[0] * v0[0] + v0[1] * v0[1]) + (v0[2] * v0[2] + v0[3] * v0[3]) + (v1[0] * v1[0] + v1[1] * v1[1]) + (v1[2] * v1[2] + v1[3] * v1[3]);
            const bf16x8 xh = __builtin_bit_cast(bf16x8, xw);
            const int ko = (32 * s + 8 * g) * 2;
            const bf16x8 bh0 = *(const LAS bf16x8*)(Th + l15 * RS + ko), bh1 = *(const LAS bf16x8*)(Th + (16 + l15) * RS + ko), bl0 = *(const LAS bf16x8*)(Tl + l15 * RS + ko), bl1 = *(const LAS bf16x8*)(Tl + (16 + l15) * RS + ko);
            a0 = __builtin_amdgcn_mfma_f32_16x16x32_bf16(xh, bh0, a0, 0, 0, 0); a0 = __builtin_amdgcn_mfma_f32_16x16x32_bf16(xh, bl0, a0, 0, 0, 0);
            a1 = __builtin_amdgcn_mfma_f32_16x16x32_bf16(xh, bh1, a1, 0, 0, 0); a1 = __builtin_amdgcn_mfma_f32_16x16x32_bf16(xh, bl1, a1, 0, 0, 0);
        }
        ssq += __shfl_xor(ssq, 16); ssq += __shfl_xor(ssq, 32);
        const float rstd = 1.0f / sqrtf(ssq * (1.f / D) + NORM_EPS);
        { unsigned char* x8 = F.ws + WS_XB + (size_t)(t0 + l15) * D + 8 * g;
#pragma unroll 1
          for (int s0 = 0; s0 < 32; s0 += 16) { u32x4 xw[16];
#pragma unroll
              for (int j = 0; j < 16; ++j) xw[j] = *(const u32x4*)(xp + 32 * (s0 + j));
#pragma unroll
              for (int j = 0; j < 16; ++j) { f32x4 v0, v1; pg8::unpack8(xw[j], v0, v1); *(u32x2*)(x8 + 32 * (s0 + j)) = pg8::pack8_fp8(v0 * rstd, v1 * rstd); } } }
        const float br0 = F.b_router[l15], br1 = F.b_router[16 + l15];
#pragma unroll
        for (int r = 0; r < 4; ++r) { const float rsr = __shfl(rstd, 4 * g + r); lg[(4 * g + r) * 33 + l15] = a0[r] * rsr + br0; lg[(4 * g + r) * 33 + 16 + l15] = a1[r] * rsr + br1; }
        LDS_WAIT(); asm volatile("" ::: "memory");
        int sel_e[4] = {0, 0, 0, 0}; float sel_g[4] = {0.f, 0.f, 0.f, 0.f}; unsigned lpos[4] = {0u, 0u, 0u, 0u};
        if (lane < 16) {
            float v[32];
#pragma unroll
            for (int e = 0; e < 32; ++e) v[e] = lg[lane * 33 + e];
            float tv[4];
#pragma unroll
            for (int k = 0; k < 4; ++k) { float best = -3.0e38f; int bi = 0;
#pragma unroll
                for (int e = 0; e < 32; ++e) { if (v[e] > best) { best = v[e]; bi = e; } }
#pragma unroll
                for (int e = 0; e < 32; ++e) { if (e == bi) v[e] = -3.0e38f; }
                tv[k] = best; sel_e[k] = bi; }
            float den = 0.f;
#pragma unroll
            for (int k = 0; k < 4; ++k) { sel_g[k] = __builtin_amdgcn_exp2f((tv[k] - tv[0]) * LOG2E); den += sel_g[k]; }
            const float idn = 1.0f / den;
#pragma unroll
            for (int k = 0; k < 4; ++k) { sel_g[k] *= idn; lpos[k] = __hip_atomic_fetch_add(lcnt + sel_e[k], 1u, __ATOMIC_RELAXED, __HIP_MEMORY_SCOPE_WORKGROUP); }
            rstd2[t0 + lane] = rstd;
        }
        __syncthreads();
        if (F.tid < 32) lbase[F.tid] = __hip_atomic_fetch_add(F.ctl + CW_CNT + 64 * F.tid, lcnt[F.tid], RLX_AGENT);
        __syncthreads();
        if (lane < 16) { const int tok = t0 + lane;
#pragma unroll
            for (int k = 0; k < 4; ++k) { const unsigned pos = lbase[sel_e[k]] + lpos[k]; rowtok[(size_t)sel_e[k] * CAP + pos] = (unsigned)tok; tokpos[tok * 4 + k] = ((unsigned)sel_e[k] << 20) | pos; tokgate[tok * 4 + k] = sel_g[k]; } }
        __syncthreads();
    }
}
__device__ __forceinline__ void moe_tables(Frame& F, LAS int* tab) {
    if (F.tid == 0) { int ts = 0, rs = 0;
        for (int e = 0; e < NE; ++e) { const int c = (int)__hip_atomic_load(F.ctl + CW_CNT + 64 * e, RLX_AGENT); tab[e] = ts; tab[40 + e] = c; tab[80 + e] = rs; ts += (c + 255) >> 8; rs += c; }
        tab[32] = ts; tab[112] = rs; }
    __syncthreads();
}
__device__ __forceinline__ void p8_combine(Frame& F, const LAS int* tab) {
    const u32x4* tokpos = (const u32x4*)(F.ws + WS_TOKPOS); const f32x4* tokgate = (const f32x4*)(F.ws + WS_TOKGATE);
    const unsigned char* Y = F.ws + WS_Y; const bf16_t* X1 = (const bf16_t*)(F.ws + WS_X1);
    const int gw = F.bx * NWAVES + F.wave, NGW = F.G * NWAVES, lane = F.lane;
    int t = gw; if (t >= M) return;
    u32x4 tp = tokpos[t]; f32x4 tg = tokgate[t];
    for (; t < M; t += NGW) {
        const int tn = (t + NGW < M) ? t + NGW : t;
        const u32x4 tpn = tokpos[tn]; const f32x4 tgn = tokgate[tn];
        u32x4 yw[4];
#pragma unroll
        for (int k = 0; k < 4; ++k) { const int e = tp[k] >> 20, pos = tp[k] & 0xfffff; const int row = tab[80 + e] + pos; yw[k] = *(const u32x4*)(Y + (size_t)row * D + 16 * lane); }
        const u32x4 xa = *(const u32x4*)(X1 + (size_t)t * D + 16 * lane), xb = *(const u32x4*)(X1 + (size_t)t * D + 16 * lane + 8);
        f32x4 o[4]; pg8::unpack8(xa, o[0], o[1]); pg8::unpack8(xb, o[2], o[3]);
#pragma unroll
        for (int k = 0; k < 4; ++k) { const float gk = tg[k];
#pragma unroll
            for (int q = 0; q < 4; ++q) { const f32x2 lo = __builtin_amdgcn_cvt_pk_f32_fp8((int)yw[k][q], false), hi = __builtin_amdgcn_cvt_pk_f32_fp8((int)yw[k][q], true);
                o[q][0] += gk * lo[0]; o[q][1] += gk * lo[1]; o[q][2] += gk * hi[0]; o[q][3] += gk * hi[1]; } }
        float* op = F.out + (size_t)t * D + 16 * lane;
#pragma unroll
        for (int q = 0; q < 4; ++q) *(f32x4*)(op + 4 * q) = o[q];
        tp = tpn; tg = tgn;
    }
}

constexpr int N_PHASES = 9;
__global__ void __launch_bounds__(NTHREADS, 2) mk_fwd(Args args) {
    extern __shared__ __attribute__((aligned(16))) unsigned char lds_raw[];
    Frame F;
    F.lds = (LAS unsigned char*)lds_raw; F.MISC = (volatile LAS unsigned*)(F.lds + LDS_MISC);
    F.tid = threadIdx.x; F.lane = F.tid & 63; F.wave = __builtin_amdgcn_readfirstlane(F.tid >> 6); F.G = gridDim.x; F.bx = blockIdx.x;
    F.ws = args.ws; F.ctl = (unsigned*)(args.ws + WS_CTL); F.out = args.out;
    F.x = args.in[0]; F.norm_mix = args.in[1]; F.w_in = args.in[2]; F.conv_w = args.in[3]; F.w_out_conv = args.in[4]; F.q_norm = args.in[5]; F.k_norm = args.in[6]; F.rpb = args.in[7];
    F.w_out_attn = args.in[8]; F.w_o = args.in[9]; F.norm_ffn = args.in[10]; F.w_router = args.in[11]; F.b_router = args.in[12]; F.w_gate = args.in[13]; F.b_gate = args.in[14];
    F.w_up = args.in[15]; F.b_up = args.in[16]; F.w_down = args.in[17]; F.b_down = args.in[18];
    if (F.tid < 64) F.MISC[F.tid] = 0u;
    __syncthreads();
    XcdBarrier bar; bar.bar = F.ctl + CW_BAR; bar.x = 0; bar.st = nullptr;
#if !MK_MULTI
    bar = xcd_barrier_post(F.ctl + CW_BAR, F.MISC + 8);
#define GRID_BAR() xcd_barrier(bar)
#else
#define GRID_BAR() do {} while (0)
#endif
    const int lo = args.ph_lo, hi = args.ph_hi;
#define IN(k) (lo <= (k) && (k) < hi)
#define SEAM(k) do { if (IN(k) && IN((k) + 1)) GRID_BAR(); } while (0)
#ifndef PROBE_NOEPI
#define PROBE_NOEPI 0
#endif
#define NOEPI_ON(k) ((PROBE_NOEPI >> (k)) & 1)
#define REPS(k) (1 + ((PROBE_REP >> (k)) & 1))
#define REP_BEGIN(k) _Pragma("unroll") for (int rep_##k = 0; rep_##k < REPS(k); ++rep_##k) { if (rep_##k > 0) GRID_BAR();
#define REP_END }
    bf16_t* Hb = (bf16_t*)F.out; bf16_t* za = (bf16_t*)F.out + (size_t)M * D;
    LAS int* tab = (LAS int*)(F.lds + LDS_TAB);

    if (IN(0)) { REP_BEGIN(0) p0_prologue(F); REP_END SEAM(0); }
    if (IN(1)) {
        pg8::DenseOrder S; S.init(Hb, F.ws + WS_WIN, M, PROJW, D * 2, F.G, F.bx);
        pg8::EpiInProj E{(bf16_t*)(F.ws + WS_U), (bf16_t*)(F.ws + WS_BG), (bf16_t*)(F.ws + WS_Q), (bf16_t*)(F.ws + WS_K), (bf16_t*)(F.ws + WS_V), (bf16_t*)(F.ws + WS_R), (bf16_t*)(F.ws + WS_SB), F.q_norm, F.k_norm};
        if constexpr (NOEPI_ON(1)) { pg8::gemm_phase<pg8::EpiInProj, pg8::DenseOrder, false, true, false, true>(F.lds, D * 2, S, E); GRID_BAR(); }
        REP_BEGIN(1) pg8::gemm_phase<pg8::EpiInProj, pg8::DenseOrder, false, true, false>(F.lds, D * 2, S, E); REP_END
        SEAM(1);
    }
    if (IN(2)) { REP_BEGIN(2) REP_BEGIN(9) p2_conv(F); REP_END REP_BEGIN(10) p2_attn(F); REP_END REP_END SEAM(2); }
    if (IN(3)) {
        pg8::DenseOrder S; S.init(za, F.ws + WS_WCA, M, D, D * 2, F.G, F.bx);
        pg8::EpiMix E{(const bf16_t*)(F.ws + WS_R), (const bf16_t*)(F.ws + WS_SB), (bf16_t*)(F.ws + WS_MIXED)};
        REP_BEGIN(3) pg8::gemm_phase<pg8::EpiMix, pg8::DenseOrder, false, true, false>(F.lds, D * 2, S, E); REP_END
        SEAM(3);
    }
    if (IN(4)) {
        pg8::DenseOrder S; S.init(F.ws + WS_MIXED, F.ws + WS_WO, M, D, D * 2, F.G, F.bx);
        pg8::EpiResid E{F.x, (bf16_t*)(F.ws + WS_X1)};
        REP_BEGIN(4) pg8::gemm_phase<pg8::EpiResid, pg8::DenseOrder, false, true, false>(F.lds, D * 2, S, E); REP_END
        SEAM(4);
    }
    if (IN(5)) { p5_router(F); SEAM(5); }
    if (IN(6)) {
        moe_tables(F, tab);
        const int ntiles = tab[32];
        pg8::MoeOrder S; S.init(F.ws + WS_XB, F.ws + WS_WGU, (const unsigned*)(F.ws + WS_ROWTOK), tab, 0, ntiles, 2 * FF, D, F.G, F.bx, true);
        pg8::EpiSwiglu E{F.b_gate, F.b_up, F.ws + WS_ACT};
        if constexpr (NOEPI_ON(6)) { pg8::gemm_phase<pg8::EpiSwiglu, pg8::MoeOrder, true, true, true, true>(F.lds, D, S, E); GRID_BAR(); }
        REP_BEGIN(6) pg8::gemm_phase<pg8::EpiSwiglu, pg8::MoeOrder, true, true, true>(F.lds, D, S, E); REP_END
        SEAM(6);
    }
    if (IN(7) || IN(8)) {
        moe_tables(F, tab);
        const int ntiles = tab[32];
        if (IN(7)) {
            pg8::EpiDown E{F.b_down, F.ws + WS_Y};
            pg8::MoeOrder S; S.init(F.ws + WS_ACT, F.ws + WS_WD, nullptr, tab, 0, ntiles, D, FF, F.G, F.bx, false);
            if constexpr (NOEPI_ON(7)) { pg8::gemm_phase<pg8::EpiDown, pg8::MoeOrder, false, true, true, true>(F.lds, FF, S, E); GRID_BAR(); }
            REP_BEGIN(7) pg8::gemm_phase<pg8::EpiDown, pg8::MoeOrder, false, true, true>(F.lds, FF, S, E); REP_END
            SEAM(7);
        }
        if (IN(8)) p8_combine(F, tab);
    }
}

extern "C" void kernel_launch(void* const* d_in, const int* in_sizes, int n_in, void* d_out, int out_size, void* d_ws, size_t ws_size, hipStream_t stream) {
    static int grid = 0;
    if (grid == 0) {
        if (n_in != 19 || out_size != M * D || ws_size < WS_END) { fprintf(stderr, "kernel_launch: unexpected shapes / workspace (%zu < %zu)\n", ws_size, (size_t)WS_END); grid = -1; return; }
        if (hipFuncSetAttribute((const void*)mk_fwd, hipFuncAttributeMaxDynamicSharedMemorySize, LDS_BYTES) != hipSuccess) { fprintf(stderr, "kernel_launch: hipFuncSetAttribute failed\n"); grid = -1; return; }
        int dev = 0, cus = 0, per_cu = 0;
        (void)hipGetDevice(&dev); (void)hipDeviceGetAttribute(&cus, hipDeviceAttributeMultiprocessorCount, dev);
        (void)hipOccupancyMaxActiveBlocksPerMultiprocessor(&per_cu, (const void*)mk_fwd, NTHREADS, LDS_BYTES);
        (void)hipGetLastError();
        grid = cus > 0 ? cus : 256;
    }
    if (grid < 0) return;
    (void)hipMemsetAsync((char*)d_ws + WS_CTL, 0, CTL_ZERO_BYTES, stream);
    Args a{};
    for (int i = 0; i < 19; ++i) a.in[i] = (const float*)d_in[i];
    a.out = (float*)d_out; a.ws = (unsigned char*)d_ws;
#if MK_MULTI
    for (int p = 0; p < N_PHASES; ++p) { a.ph_lo = p; a.ph_hi = p + 1; hipLaunchKernelGGL(mk_fwd, dim3(grid), dim3(NTHREADS), LDS_BYTES, stream, a); }
#else
    a.ph_lo = 0; a.ph_hi = N_PHASES;
    hipLaunchKernelGGL(mk_fwd, dim3(grid), dim3(NTHREADS), LDS_BYTES, stream, a);
#endif
}
```

```cpp
#include <hip/hip_runtime.h>
#include <cstdio>
#include <cstdint>

#ifndef MK_MULTI
#define MK_MULTI 0
#endif

#ifndef PROBE_REP
#define PROBE_REP 0
#endif
#define LAS __attribute__((address_space(3)))
#define GAS __attribute__((address_space(1)))
typedef unsigned short bf16_t;
typedef short bf16x8 __attribute__((ext_vector_type(8)));
typedef short s16x4 __attribute__((ext_vector_type(4)));
typedef float f32x4 __attribute__((ext_vector_type(4)));
typedef float f32x2 __attribute__((ext_vector_type(2)));
typedef unsigned u32x4 __attribute__((ext_vector_type(4)));
typedef unsigned u32x2 __attribute__((ext_vector_type(2)));

constexpr int D = 1024, NB = 8, SEQ = 4096, M = NB * SEQ;
constexpr int CONVW = 512, NH = 8, HD = 64, ATTW = 512, PROJW = 5120;
constexpr int NE = 32, TOPK = 4, FF = 1024, NASG = M * TOPK, CAP = M;
constexpr float NORM_EPS = 1e-6f, LOG2E = 1.4426950408889634f;
constexpr int NTHREADS = 512, NWAVES = 8;

constexpr size_t MiB = 1u << 20;
constexpr size_t WS_CTL = 0, CTL_ZERO_BYTES = 64 * 1024;
constexpr size_t WS_WRH = 1 * MiB, WS_WRL = 1 * MiB + 65536;
constexpr size_t WS_ROWTOK = 2 * MiB;
constexpr size_t WS_TOKPOS = 6 * MiB, WS_TOKGATE = 6 * MiB + 512 * 1024;
constexpr size_t WS_RSTD2 = 7 * MiB;
constexpr size_t WS_WIN = 8 * MiB, WS_WCA = 18 * MiB, WS_WO = 20 * MiB;
constexpr size_t WS_WD = 24 * MiB, WS_WGU = 56 * MiB;
constexpr size_t WS_XB = 120 * MiB;
constexpr size_t WS_ACT = 152 * MiB;
constexpr size_t WS_Y = 281 * MiB;
constexpr size_t WS_X1 = 409 * MiB;
constexpr size_t WS_END = WS_X1 + (size_t)M * D * 2;
static_assert(WS_ACT + (size_t)(NASG + 256) * FF <= WS_Y && WS_Y + (size_t)NASG * D <= WS_X1, "ws map");
constexpr size_t WS_U = 152 * MiB, WS_BG = 184 * MiB, WS_Q = 216 * MiB, WS_K = 248 * MiB, WS_V = 280 * MiB, WS_R = 312 * MiB, WS_SB = 376 * MiB;
constexpr size_t WS_MIXED = 152 * MiB;
constexpr float WSCALE = 64.0f, WINV = 1.0f / 64.0f;
constexpr int CW_TMO = 0, CW_CNT = 64  , CW_BAR = 4096;

constexpr int RING_BYTES = 131072;
constexpr int LDS_X = 132096;
constexpr int LDS_TAB = 148992;
constexpr int LDS_CNT = 149504;
constexpr int LDS_MISC = 149760;
constexpr int LDS_BYTES = 163840;
static_assert(LDS_MISC + 256 <= LDS_BYTES, "lds map");

#define RLX_AGENT __ATOMIC_RELAXED, __HIP_MEMORY_SCOPE_AGENT
#define LDS_WAIT() asm volatile("s_waitcnt lgkmcnt(0)" ::: "memory")
#define VM_WAIT() asm volatile("s_waitcnt vmcnt(0)" ::: "memory")
__device__ __forceinline__ unsigned cvt_pk_bf16(float lo, float hi) { unsigned r; asm volatile("v_cvt_pk_bf16_f32 %0, %1, %2" : "=v"(r) : "v"(lo), "v"(hi)); return r; }
__device__ __forceinline__ float bf_lo(unsigned w) { return __uint_as_float(w << 16); }
__device__ __forceinline__ float bf_hi(unsigned w) { return __uint_as_float(w & 0xffff0000u); }
__device__ __forceinline__ int clampi(int v, int lo, int hi) { return v < lo ? lo : (v > hi ? hi : v); }

#define XB_TMO      128
#define XB_XCNT(j)  (256  + 64 * (j))
#define XB_XSUB(j)  (1280 + 64 * (j))
#define XB_XGEN(j)  (2304 + 64 * (j))
#define XB_TOP      3328
#define XB_TOPGEN   3392
#define XCD_BAR_WORDS 3456
#define XB_SPIN_CAP (1u << 18)
__device__ __forceinline__ unsigned xb_ld(unsigned* p)              { return __hip_atomic_load(p, __ATOMIC_RELAXED, __HIP_MEMORY_SCOPE_AGENT); }
__device__ __forceinline__ unsigned xb_add(unsigned* p, unsigned v) { return __hip_atomic_fetch_add(p, v, __ATOMIC_RELAXED, __HIP_MEMORY_SCOPE_AGENT); }
__device__ __forceinline__ unsigned xb_xcc_id() { return (unsigned)__builtin_amdgcn_s_getreg((3 << 11) | 20) & 0xFu; }
#define XB_SPIN(cond, bar) do { unsigned _sp = 0; while (cond) { __builtin_amdgcn_s_sleep(1); \
    if ((++_sp & 255u) == 0u) { if (xb_ld(&(bar)[XB_TMO])) break; if (_sp > XB_SPIN_CAP) { atomicAdd(&(bar)[XB_TMO], 1u); break; } } } } while (0)
struct XcdBarrier { unsigned* bar; unsigned x; volatile LAS unsigned* st; };
__device__ __forceinline__ XcdBarrier xcd_barrier_post(unsigned* bar, volatile LAS unsigned* st) {
    XcdBarrier b; b.bar = bar; b.x = xb_xcc_id(); b.st = st;
    if (threadIdx.x == 0) (void)xb_add(&bar[XB_XCNT(b.x)], 1u);
    return b;
}
__device__ __forceinline__ void xcd_barrier_complete(unsigned* bar, unsigned x, unsigned& nloc, unsigned& nx) {
    const unsigned G = gridDim.x * gridDim.y * gridDim.z;
    unsigned sum, cnt, mine, sp = 0u;
    for (;;) {
        sum = 0u; cnt = 0u; mine = 0u;
#pragma unroll
        for (unsigned j = 0; j < 16; ++j) { const unsigned c = xb_ld(&bar[XB_XCNT(j)]); sum += c; cnt += (c > 0u) ? 1u : 0u; mine = (j == x) ? c : mine; }
        if (sum == G) break;
        __builtin_amdgcn_s_sleep(1);
        if ((++sp & 255u) == 0u) { if (xb_ld(&bar[XB_TMO])) break; if (sp > XB_SPIN_CAP) { atomicAdd(&bar[XB_TMO], 1u); break; } }
    }
    nloc = mine > 0u ? mine : 1u; nx = cnt > 0u ? cnt : 1u;
}
__device__ __forceinline__ void xcd_barrier(const XcdBarrier& b) {
    asm volatile("s_waitcnt vmcnt(0)" ::: "memory");
    __syncthreads();
    if (threadIdx.x == 0) {
        unsigned* bar = b.bar;
        __builtin_amdgcn_s_waitcnt(0);
        unsigned nloc = b.st[0], nx = b.st[1];
        if (nloc == 0u) { xcd_barrier_complete(bar, b.x, nloc, nx); b.st[0] = nloc; b.st[1] = nx; }
        const unsigned old = xb_add(&bar[XB_XSUB(b.x)], 1u);
        const unsigned gen = old / nloc;
        if (old + 1u == (gen + 1u) * nloc) {
            __builtin_amdgcn_fence(__ATOMIC_RELEASE, "agent");
            asm volatile("s_waitcnt vmcnt(0)" ::: "memory");
            const unsigned og = xb_add(&bar[XB_TOP], 1u);
            const unsigned tg = og / nx;
            if (og + 1u == (tg + 1u) * nx) xb_add(&bar[XB_TOPGEN], 1u);
            else XB_SPIN(xb_ld(&bar[XB_TOPGEN]) == tg, bar);
            __builtin_amdgcn_fence(__ATOMIC_ACQUIRE, "agent");
            xb_add(&bar[XB_XGEN(b.x)], 1u);
            asm volatile("s_waitcnt vmcnt(0)" ::: "memory");
        } else {
            XB_SPIN(xb_ld(&bar[XB_XGEN(b.x)]) == gen, bar);
            __builtin_amdgcn_fence(__ATOMIC_ACQUIRE, "agent");
            asm volatile("s_waitcnt vmcnt(0)" ::: "memory");
        }
    }
    __syncthreads();
}

namespace pg8 {
constexpr int BM = 256, BK = 64, HALF = 128, HTB = HALF * BK * 2, NXCD = 8, WGM = 8;
__host__ __device__ __forceinline__ int lds_byte(int r, int c) { const int st = (r >> 4) * 2 + (c >> 5), rr = r & 15, cc = c & 31, ob = rr * 64 + cc * 2; return st * 1024 + (ob ^ (((ob >> 9) & 1) << 5)); }
__host__ __device__ __forceinline__ void stage_rc(int b, int& R, int& C) { const int st = b / 1024, sb = b % 1024, swz = sb ^ (((sb >> 9) & 1) << 5); R = (st >> 1) * 16 + swz / 64; C = (st & 1) * 32 + (swz % 64) / 2; }
__host__ __device__ __forceinline__ int perm32(int rho) { const int n = rho >> 4, i = rho & 15; return 8 * (i >> 2) + 4 * n + (i & 3); }

struct Unit { int pm, pn, e, nvalid, rowbase, lbase; };

struct DenseOrder {
    const char* A; const char* Bt; int nM, nN, nwg, G, c; size_t tstep;
    __device__ void init(const void* A_, const void* Bt_, int Mr, int N, int KB  , int G_, int c_) { A = (const char*)A_; Bt = (const char*)Bt_; nM = Mr / BM; nN = N / BM; nwg = nM * nN; G = G_; c = c_; tstep = (size_t)BM * KB; }
    __device__ __forceinline__ bool next(int i, Unit& u) const {
        const long L = (long)i * G + c; if (L >= nwg) return false;
        int wgid = (int)L; { const int q = nwg / NXCD, r = nwg % NXCD, xcd = wgid % NXCD, off = wgid / NXCD; wgid = (xcd < r ? xcd * (q + 1) : r * (q + 1) + (xcd - r) * q) + off; }
        const int nig = WGM * nN, gid = wgid / nig, fm = gid * WGM, gsz = (nM - fm) < WGM ? (nM - fm) : WGM;
        u.pm = fm + ((wgid % nig) % gsz); u.pn = (wgid % nig) / gsz; u.e = 0; u.nvalid = BM; u.rowbase = 0; u.lbase = 0; return true;
    }
    __device__ __forceinline__ unsigned a_off(const Unit& u) const { return (unsigned)u.pm * (unsigned)tstep; }
    __device__ __forceinline__ unsigned b_off(const Unit& u) const { return (unsigned)u.pn * (unsigned)tstep; }
    __device__ __forceinline__ unsigned row_tok(const Unit&, int) const { return 0u; }
};

struct MoeOrder {
    const char* A; const char* Bt; const unsigned* rowtok; const LAS int* tab; int tlo, nT, nN, nwg, G, c; size_t tstep, estride, rowbytes; bool gather;
    __device__ void init(const void* A_, const void* Bt_, const unsigned* rowtok_, const LAS int* tab_, int tlo_, int thi_, int N, int KB  , int G_, int c_, bool gather_) {
        A = (const char*)A_; Bt = (const char*)Bt_; rowtok = rowtok_; tab = tab_; tlo = tlo_; nT = thi_ - tlo_; if (nT < 0) nT = 0; nN = N / BM; nwg = nT * nN; G = G_; c = c_;
        tstep = (size_t)BM * KB; estride = (size_t)N * KB; rowbytes = (size_t)KB; gather = gather_; }
    __device__ __forceinline__ bool next(int i, Unit& u) const {
        const long L = (long)i * G + c; if (L >= nwg) return false;
        int wgid = (int)L; { const int q = nwg / NXCD, r = nwg % NXCD, xcd = wgid % NXCD, off = wgid / NXCD; wgid = (xcd < r ? xcd * (q + 1) : r * (q + 1) + (xcd - r) * q) + off; }
        const int nig = WGM * nN, gid = wgid / nig, fm = gid * WGM, gsz = (nT - fm) < WGM ? (nT - fm) : WGM;
        const int gt = tlo + fm + ((wgid % nig) % gsz), pn = (wgid % nig) / gsz;
        const int lane = threadIdx.x & 63;
        const int ts = (lane < 32) ? tab[lane] : 0x7fffffff;
        const unsigned long long mask = __ballot(ts <= gt);
        const int e = __builtin_popcountll(mask) - 1;
        const int j = gt - __builtin_amdgcn_readfirstlane(tab[e]);
        const int cnt = __builtin_amdgcn_readfirstlane(tab[40 + e]), es = __builtin_amdgcn_readfirstlane(tab[80 + e]);
        u.pm = gt; u.pn = pn; u.e = e; const int nv = cnt - 256 * j; u.nvalid = nv > 256 ? 256 : nv; u.rowbase = es + 256 * j; u.lbase = e * CAP + 256 * j; return true;
    }
    __device__ __forceinline__ unsigned a_off(const Unit& u) const { return gather ? 0u : (unsigned)u.rowbase * (unsigned)rowbytes; }
    __device__ __forceinline__ unsigned b_off(const Unit& u) const { return (unsigned)u.e * (unsigned)estride + (unsigned)u.pn * (unsigned)tstep; }
    __device__ __forceinline__ unsigned row_tok(const Unit& u, int r) const { const int rr = r < u.nvalid ? r : 0; return rowtok[u.lbase + rr]; }
};

typedef int v8i __attribute__((ext_vector_type(8))); typedef int v4i __attribute__((ext_vector_type(4)));
__device__ __forceinline__ v8i cat8(const bf16x8 a, const bf16x8 b) { return __builtin_shufflevector(__builtin_bit_cast(v4i, a), __builtin_bit_cast(v4i, b), 0, 1, 2, 3, 4, 5, 6, 7); }
template <class Epi, class Sched, bool GATHER, bool ALIGN_EPI, bool FP8, bool NOEPI = false>
__device__ __forceinline__ void gemm_phase(LAS unsigned char* lds, const int KB, const Sched& S, const Epi& E) {
    const int tid = threadIdx.x, wid = __builtin_amdgcn_readfirstlane(tid >> 6), lane = tid & 63, wr = wid >> 2, wc = wid & 3, fr = lane & 15, fq = lane >> 4;
    const int nt = KB / 128;
    int Rst[2], Cst[2]; unsigned voffB[2];
#pragma unroll
    for (int i = 0; i < 2; ++i) { int R, C; stage_rc(tid * 16 + i * 8192, R, C); Rst[i] = R; Cst[i] = C; const int Rb = (R & ~31) + perm32(R & 31); voffB[i] = (unsigned)(Rb * KB + C * 2); }
    const unsigned kstep = 128u;
    const unsigned hstep = (unsigned)HALF * (unsigned)KB;
    const __amdgpu_buffer_rsrc_t rsA = __builtin_amdgcn_make_buffer_rsrc((void*)S.A, 0, 0x7ffffff0, 0x00020000), rsB = __builtin_amdgcn_make_buffer_rsrc((void*)S.Bt, 0, 0x7ffffff0, 0x00020000);
    const unsigned ldsw = (unsigned)wid * 1024u;
    const int aoff = lds_byte(wr * 64 + fr, fq * 8), boff = lds_byte(wc * 32 + fr, fq * 8);
#define PG8_SA(b, h) (((b) * 2 + (h)) * HTB)
#define PG8_SB(b, h) ((4 + (b) * 2 + (h)) * HTB)
#define PG8_GLDS(rs, voff, soff, ldsoff) __builtin_amdgcn_raw_ptr_buffer_load_lds(rs, (LAS unsigned*)(lds + (ldsoff)), 16, (int)(voff), (int)(soff), 0, 0)
#define PG8_STAGE_B(bufoff, soff) do { PG8_GLDS(rsB, voffB[0], soff, (bufoff) + ldsw); PG8_GLDS(rsB, voffB[1], soff, (bufoff) + ldsw + 8192); } while (0)
#define PG8_STAGE_A(bufoff, soff, o0, o1) do { PG8_GLDS(rsA, o0, soff, (bufoff) + ldsw); PG8_GLDS(rsA, o1, soff, (bufoff) + ldsw + 8192); } while (0)
#define PG8_LDA(dst, b, h) do { _Pragma("unroll") for (int m = 0; m < 4; ++m) _Pragma("unroll") for (int k = 0; k < 2; ++k) dst[m][k] = *(const LAS bf16x8*)(lds + PG8_SA(b, h) + aoff + m * 2048 + k * 1024); } while (0)
#define PG8_LDB(dst, b, h) do { _Pragma("unroll") for (int n = 0; n < 2; ++n) _Pragma("unroll") for (int k = 0; k < 2; ++k) dst[n][k] = *(const LAS bf16x8*)(lds + PG8_SB(b, h) + boff + n * 2048 + k * 1024); } while (0)
#define PG8_MMA(ai, bj, At, Bt) do { __builtin_amdgcn_s_setprio(1); _Pragma("unroll") for (int m = 0; m < 4; ++m) _Pragma("unroll") for (int n = 0; n < 2; ++n) { \
        if constexpr (FP8) { const v8i b8_ = cat8(Bt[n][0], Bt[n][1]), a8_ = cat8(At[m][0], At[m][1]); asm volatile("v_mfma_f32_16x16x128_f8f6f4 %0, %1, %2, %0" : "+v"(acc[ai][bj][m][n]) : "v"(b8_), "v"(a8_)); } \
        else { _Pragma("unroll") for (int k = 0; k < 2; ++k) acc[ai][bj][m][n] = __builtin_amdgcn_mfma_f32_16x16x32_bf16(Bt[n][k], At[m][k], acc[ai][bj][m][n], 0, 0, 0); } } \
        __builtin_amdgcn_s_setprio(0); } while (0)
#define PG8_WAIT_V(n) asm volatile("s_waitcnt vmcnt(" #n ")" ::: "memory")
#define PG8_WAIT_L(n) asm volatile("s_waitcnt lgkmcnt(" #n ")" ::: "memory")
#define PG8_BAR __builtin_amdgcn_s_barrier()
#define PG8_SCHED __builtin_amdgcn_sched_barrier(0)
    Unit cur, nxt, nn; int ui = 0;
    if (!S.next(0, cur)) return;
    bool has_next = S.next(1, nxt);
    unsigned coff[2][2], noff[2][2];
#pragma unroll
    for (int h = 0; h < 2; ++h)
#pragma unroll
        for (int i = 0; i < 2; ++i) {
            if constexpr (GATHER) { coff[h][i] = S.row_tok(cur, h * HALF + Rst[i]) * (unsigned)KB + (unsigned)Cst[i] * 2u;
                                    noff[h][i] = has_next ? S.row_tok(nxt, h * HALF + Rst[i]) * (unsigned)KB + (unsigned)Cst[i] * 2u : coff[h][i]; }
            else { coff[h][i] = (unsigned)((h * HALF + Rst[i]) * KB + Cst[i] * 2); noff[h][i] = coff[h][i]; }
        }
    f32x4 acc[2][2][4][2];
#pragma unroll
    for (int a = 0; a < 2; ++a)
#pragma unroll
        for (int b = 0; b < 2; ++b)
#pragma unroll
            for (int m = 0; m < 4; ++m)
#pragma unroll
                for (int n = 0; n < 2; ++n) acc[a][b][m][n] = (f32x4){0.f, 0.f, 0.f, 0.f};
    bf16x8 At[4][2], B0[2][2], B1[2][2];
    unsigned cA = S.a_off(cur), cB = S.b_off(cur);
    PG8_STAGE_B(PG8_SB(0, 0), cB); PG8_STAGE_B(PG8_SB(0, 1), cB + hstep); PG8_STAGE_A(PG8_SA(0, 0), cA, coff[0][0], coff[0][1]); PG8_STAGE_A(PG8_SA(0, 1), cA, coff[1][0], coff[1][1]);
    if (wr == 1) PG8_BAR;
    PG8_WAIT_V(2); PG8_BAR;
    PG8_STAGE_B(PG8_SB(1, 0), cB + kstep); PG8_STAGE_A(PG8_SA(1, 0), cA + kstep, coff[0][0], coff[0][1]); PG8_STAGE_B(PG8_SB(1, 1), cB + hstep + kstep);
    PG8_WAIT_V(6); PG8_BAR;
    for (;;) {
        if constexpr (!GATHER) { if (ui > 0) has_next = S.next(ui + 1, nxt); }
        const unsigned nA = has_next ? S.a_off(nxt) : cA, nB = has_next ? S.b_off(nxt) : cB;
#pragma unroll 1
        for (int t = 0; t < nt; t += 2) {
            const bool last = (t == nt - 2);
            if constexpr (Epi::HAS_MID) { if (t == nt / 2) E.mid(acc, cur, wr, wc, fr, fq); }
            const unsigned a1 = cA + (unsigned)(t + 1) * kstep;
            const unsigned a2 = last ? nA : cA + (unsigned)(t + 2) * kstep, b2 = last ? nB : cB + (unsigned)(t + 2) * kstep;
            const unsigned a3 = a2 + kstep, b3 = b2 + kstep;
            unsigned x00, x01, x10, x11;
            if constexpr (GATHER) { x00 = last ? noff[0][0] : coff[0][0]; x01 = last ? noff[0][1] : coff[0][1]; x10 = last ? noff[1][0] : coff[1][0]; x11 = last ? noff[1][1] : coff[1][1]; }
            else { x00 = coff[0][0]; x01 = coff[0][1]; x10 = coff[1][0]; x11 = coff[1][1]; }
            PG8_LDB(B0, 0, 0); PG8_LDB(B1, 0, 1); PG8_SCHED; PG8_LDA(At, 0, 0); PG8_STAGE_A(PG8_SA(1, 1), a1, coff[1][0], coff[1][1]);
            PG8_WAIT_V(8); PG8_WAIT_L(0); PG8_BAR; PG8_MMA(0, 0, At, B0); PG8_MMA(0, 1, At, B1); PG8_BAR; PG8_SCHED;
            PG8_LDA(At, 0, 1); PG8_STAGE_B(PG8_SB(0, 0), b2); PG8_STAGE_B(PG8_SB(0, 1), b2 + hstep); PG8_STAGE_A(PG8_SA(0, 0), a2, x00, x01);
            PG8_WAIT_V(8); PG8_WAIT_L(0); PG8_BAR; PG8_MMA(1, 0, At, B0); PG8_MMA(1, 1, At, B1); PG8_BAR; PG8_SCHED;
            PG8_LDB(B0, 1, 0); PG8_LDB(B1, 1, 1); PG8_SCHED; PG8_LDA(At, 1, 0); PG8_STAGE_A(PG8_SA(0, 1), a2, x10, x11);
            PG8_WAIT_V(8); PG8_WAIT_L(0); PG8_BAR; PG8_MMA(0, 0, At, B0); PG8_MMA(0, 1, At, B1); PG8_BAR; PG8_SCHED;
            PG8_LDA(At, 1, 1); PG8_STAGE_B(PG8_SB(1, 0), b3); PG8_STAGE_B(PG8_SB(1, 1), b3 + hstep); PG8_STAGE_A(PG8_SA(1, 0), a3, x00, x01);
            PG8_WAIT_V(8); PG8_WAIT_L(0); PG8_BAR; PG8_MMA(1, 0, At, B0); PG8_MMA(1, 1, At, B1); PG8_BAR; PG8_SCHED;
        }
        if constexpr (FP8) asm volatile("s_nop 15\n\ts_nop 15" ::: "memory");
        if constexpr (ALIGN_EPI) { if (wr == 0) PG8_BAR; }
        bool has_nn = false; unsigned pend[2][2] = {{0u, 0u}, {0u, 0u}};
        if constexpr (GATHER) {
            has_nn = has_next && S.next(ui + 2, nn);
            if (has_nn) {
#pragma unroll
                for (int h = 0; h < 2; ++h)
#pragma unroll
                    for (int i = 0; i < 2; ++i) pend[h][i] = S.row_tok(nn, h * HALF + Rst[i]); }
        }
        if constexpr (NOEPI) {
#pragma unroll
            for (int a = 0; a < 2; ++a)
#pragma unroll
                for (int b = 0; b < 2; ++b)
#pragma unroll
                    for (int m = 0; m < 4; ++m) asm volatile("" :: "v"(acc[a][b][m][0]), "v"(acc[a][b][m][1]));
        } else E(acc, cur, wr, wc, fr, fq);
        if (!has_next) break;
#pragma unroll
        for (int a = 0; a < 2; ++a)
#pragma unroll
            for (int b = 0; b < 2; ++b)
#pragma unroll
                for (int m = 0; m < 4; ++m)
#pragma unroll
                    for (int n = 0; n < 2; ++n) acc[a][b][m][n] = (f32x4){0.f, 0.f, 0.f, 0.f};
        cur = nxt; cA = nA; cB = nB; ++ui;
        if constexpr (GATHER) {
#pragma unroll
            for (int h = 0; h < 2; ++h)
#pragma unroll
                for (int i = 0; i < 2; ++i) { coff[h][i] = noff[h][i]; if (has_nn) noff[h][i] = pend[h][i] * (unsigned)KB + (unsigned)Cst[i] * 2u; }
            nxt = nn; has_next = has_nn;
        }
        if constexpr (ALIGN_EPI) { if (wr == 1) PG8_BAR; }
    }
    PG8_WAIT_V(0);
    if constexpr (!ALIGN_EPI) { if (wr == 0) PG8_BAR; }
    PG8_BAR;
#undef PG8_SA
#undef PG8_SB
#undef PG8_GLDS
#undef PG8_STAGE_A
#undef PG8_STAGE_B
#undef PG8_LDA
#undef PG8_LDB
#undef PG8_MMA
#undef PG8_WAIT_V
#undef PG8_WAIT_L
#undef PG8_BAR
#undef PG8_SCHED
}

typedef f32x4 Acc[2][2][4][2];
#ifndef EPI_NT
#define EPI_NT 0
#endif
#if EPI_NT
#define NT_STORE(T, p, v) __builtin_nontemporal_store((T)(v), (T*)(p))
#else
#define NT_STORE(T, p, v) (*(T*)(p) = (v))
#endif
__device__ __forceinline__ u32x4 pack8(const f32x4 a, const f32x4 b) { u32x4 w; w.x = cvt_pk_bf16(a[0], a[1]); w.y = cvt_pk_bf16(a[2], a[3]); w.z = cvt_pk_bf16(b[0], b[1]); w.w = cvt_pk_bf16(b[2], b[3]); return w; }
__device__ __forceinline__ unsigned pk_fp8x4(float a, float b, float c, float d) { int w = __builtin_amdgcn_cvt_pk_fp8_f32(a, b, 0, false); w = __builtin_amdgcn_cvt_pk_fp8_f32(c, d, w, true); return (unsigned)w; }
__device__ __forceinline__ u32x2 pack8_fp8(const f32x4 a, const f32x4 b) { u32x2 w; w.x = pk_fp8x4(a[0], a[1], a[2], a[3]); w.y = pk_fp8x4(b[0], b[1], b[2], b[3]); return w; }
__device__ __forceinline__ void unpack8(const u32x4 w, f32x4& a, f32x4& b) { a = (f32x4){bf_lo(w.x), bf_hi(w.x), bf_lo(w.y), bf_hi(w.y)}; b = (f32x4){bf_lo(w.z), bf_hi(w.z), bf_lo(w.w), bf_hi(w.w)}; }

struct EpiInProj {
    static constexpr bool HAS_MID = false;
    bf16_t *U, *Bg, *Q, *Kk, *V, *R, *SB; const float *qn, *kn;
    __device__ __forceinline__ void operator()(const Acc& acc, const Unit& u, int wr, int wc, int fr, int fq) const {
        const int t = u.pn; const size_t row0 = (size_t)u.pm * BM + wr * 64 + fr; const int cb = wc * 32 + 8 * fq;
        if (t < 4) {
#pragma unroll
            for (int ai = 0; ai < 2; ++ai)
#pragma unroll
                for (int m = 0; m < 4; ++m) { const size_t r = row0 + ai * HALF + m * 16;
                    NT_STORE(u32x4, (U + r * CONVW + t * 128 + cb), (pack8(acc[ai][0][m][0] * acc[ai][1][m][0], acc[ai][0][m][1] * acc[ai][1][m][1]))); }
        } else if (t < 6 || t == 10 || t == 11) {
            bf16_t* base = (t < 6) ? Bg + (t - 4) * 256 : V + (t - 10) * 256;
#pragma unroll
            for (int ai = 0; ai < 2; ++ai)
#pragma unroll
                for (int m = 0; m < 4; ++m) { const size_t r = row0 + ai * HALF + m * 16;
#pragma unroll
                    for (int bj = 0; bj < 2; ++bj) NT_STORE(u32x4, (base + r * 512 + bj * HALF + cb), (pack8(acc[ai][bj][m][0], acc[ai][bj][m][1]))); }
        } else if (t < 10) {
            const bool isq = t < 8; bf16_t* base = isq ? Q : Kk; const float* gn = isq ? qn : kn; const float sc = isq ? 0.125f * LOG2E : 1.0f;
            const int hh = 4 * (t & 1) + wc;
            f32x4 g[2][2];
#pragma unroll
            for (int bj = 0; bj < 2; ++bj) { g[bj][0] = *(const f32x4*)(gn + 32 * bj + 8 * fq) * sc; g[bj][1] = *(const f32x4*)(gn + 32 * bj + 8 * fq + 4) * sc; }
#pragma unroll
            for (int ai = 0; ai < 2; ++ai)
#pragma unroll
                for (int m = 0; m < 4; ++m) { const size_t r = row0 + ai * HALF + m * 16; float ss = 0.f;
#pragma unroll
                    for (int bj = 0; bj < 2; ++bj)
#pragma unroll
                        for (int n = 0; n < 2; ++n) { const f32x4 v = acc[ai][bj][m][n]; ss += (v[0] * v[0] + v[1] * v[1]) + (v[2] * v[2] + v[3] * v[3]); }
                    ss += __shfl_xor(ss, 16); ss += __shfl_xor(ss, 32);
                    const float rinv = __builtin_amdgcn_rsqf(ss * (1.0f / 64.0f) + NORM_EPS);
#pragma unroll
                    for (int bj = 0; bj < 2; ++bj) NT_STORE(u32x4, (base + r * 512 + hh * 64 + 32 * bj + 8 * fq), (pack8(acc[ai][bj][m][0] * rinv * g[bj][0], acc[ai][bj][m][1] * rinv * g[bj][1]))); }
        } else {
            const int gi = t - 12;
#pragma unroll
            for (int ai = 0; ai < 2; ++ai)
#pragma unroll
                for (int m = 0; m < 4; ++m) { const size_t r = row0 + ai * HALF + m * 16; f32x4 rr[2], sb[2];
#pragma unroll
                    for (int n = 0; n < 2; ++n)
#pragma unroll
                        for (int j = 0; j < 4; ++j) { float a = acc[ai][0][m][n][j], b = acc[ai][1][m][n][j];
                            a = fminf(fmaxf(a, -30.f), 30.f); b = fminf(fmaxf(b, -30.f), 30.f);
                            const float ea = __builtin_amdgcn_exp2f(-a * LOG2E), eb = __builtin_amdgcn_exp2f(-b * LOG2E);
                            const float ia = __builtin_amdgcn_rcpf(1.f + ea), ib = __builtin_amdgcn_rcpf(1.f + eb);
                            rr[n][j] = (1.f + eb) * ia; sb[n][j] = ib; }
                    NT_STORE(u32x4, (R + r * D + gi * 128 + cb), (pack8(rr[0], rr[1]))); NT_STORE(u32x4, (SB + r * D + gi * 128 + cb), (pack8(sb[0], sb[1]))); }
        }
    }
};
struct EpiMix {
    static constexpr bool HAS_MID = true;
    const bf16_t *R, *SB; bf16_t* O;
    __device__ __forceinline__ void mid(Acc& acc, const Unit& u, int wr, int wc, int fr, int fq) const {
        const size_t row0 = (size_t)u.pm * BM + wr * 64 + fr; const int col0 = u.pn * BM + wc * 32 + 8 * fq;
#pragma unroll
        for (int ai = 0; ai < 2; ++ai)
#pragma unroll
            for (int m = 0; m < 4; ++m) { const size_t r = row0 + ai * HALF + m * 16;
#pragma unroll
                for (int bj = 0; bj < 2; ++bj) { f32x4 a, b; unpack8(*(const u32x4*)(R + r * D + col0 + bj * HALF), a, b); acc[ai][bj][m][0] *= a; acc[ai][bj][m][1] *= b; } }
    }
    __device__ __forceinline__ void operator()(const Acc& acc, const Unit& u, int wr, int wc, int fr, int fq) const {
        const size_t row0 = (size_t)u.pm * BM + wr * 64 + fr; const int col0 = u.pn * BM + wc * 32 + 8 * fq;
#pragma unroll
        for (int ai = 0; ai < 2; ++ai)
#pragma unroll
            for (int m = 0; m < 4; ++m) { const size_t r = row0 + ai * HALF + m * 16;
#pragma unroll
                for (int bj = 0; bj < 2; ++bj) { f32x4 a, b; unpack8(*(const u32x4*)(SB + r * D + col0 + bj * HALF), a, b);
                    NT_STORE(u32x4, (O + r * D + col0 + bj * HALF), (pack8(acc[ai][bj][m][0] * a, acc[ai][bj][m][1] * b))); } }
    }
};
struct EpiResid {
    static constexpr bool HAS_MID = false;
    const float* X; bf16_t* O;
    __device__ __forceinline__ void operator()(const Acc& acc, const Unit& u, int wr, int wc, int fr, int fq) const {
        const size_t row0 = (size_t)u.pm * BM + wr * 64 + fr; const int col0 = u.pn * BM + wc * 32 + 8 * fq;
#pragma unroll
        for (int ai = 0; ai < 2; ++ai)
#pragma unroll
            for (int m = 0; m < 4; ++m) { const size_t r = row0 + ai * HALF + m * 16;
#pragma unroll
                for (int bj = 0; bj < 2; ++bj) { const size_t o = r * D + col0 + bj * HALF;
                    const f32x4 v0 = *(const f32x4*)(X + o) + acc[ai][bj][m][0], v1 = *(const f32x4*)(X + o + 4) + acc[ai][bj][m][1];
                    NT_STORE(u32x4, (O + o), (pack8(v0, v1))); } }
    }
};
struct EpiSwiglu {
    static constexpr bool HAS_MID = false;
    const float *bg, *bu; unsigned char* act;
    __device__ __forceinline__ void operator()(const Acc& acc, const Unit& u, int wr, int wc, int fr, int fq) const {
        asm volatile("" : "+v"(fr), "+v"(fq));
        const int f0 = u.pn * 128 + wc * 32 + 8 * fq;
        f32x4 g0 = *(const f32x4*)(bg + u.e * FF + f0), g1 = *(const f32x4*)(bg + u.e * FF + f0 + 4), u0 = *(const f32x4*)(bu + u.e * FF + f0), u1 = *(const f32x4*)(bu + u.e * FF + f0 + 4);
#pragma unroll
        for (int ai = 0; ai < 2; ++ai)
#pragma unroll
            for (int m = 0; m < 4; ++m) { const int rl = ai * HALF + wr * 64 + m * 16 + fr;
                if (rl < u.nvalid) {
                    const float rs = WINV;
                    f32x4 o[2];
#pragma unroll
                    for (int n = 0; n < 2; ++n)
#pragma unroll
                        for (int j = 0; j < 4; ++j) { const float gb = n ? g1[j] : g0[j], ub = n ? u1[j] : u0[j];
                            float g = fminf(acc[ai][0][m][n][j] * rs + gb, 7.0f); float uu = fminf(fmaxf(acc[ai][1][m][n][j] * rs + ub, -7.0f), 7.0f);
                            const float sg = __builtin_amdgcn_rcpf(1.f + __builtin_amdgcn_exp2f(-1.702f * LOG2E * g));
                            o[n][j] = g * sg * (uu + 1.0f); }
                    NT_STORE(u32x2, (act + (size_t)(u.rowbase + rl) * FF + f0), (pack8_fp8(o[0], o[1]))); } }
        asm volatile("" :: "v"(g0), "v"(g1), "v"(u0), "v"(u1));
    }
};
struct EpiDown {
    static constexpr bool HAS_MID = false;
    const float* bd; unsigned char* Y;
    __device__ __forceinline__ void operator()(const Acc& acc, const Unit& u, int wr, int wc, int fr, int fq) const {
        asm volatile("" : "+v"(fr), "+v"(fq));
        const int col0 = u.pn * BM + wc * 32 + 8 * fq;
        unsigned char* yb = Y + (size_t)u.rowbase * D;
        f32x4 b[2][2];
#pragma unroll
        for (int bj = 0; bj < 2; ++bj) { b[bj][0] = *(const f32x4*)(bd + u.e * D + col0 + bj * HALF); b[bj][1] = *(const f32x4*)(bd + u.e * D + col0 + bj * HALF + 4); }
#pragma unroll
        for (int ai = 0; ai < 2; ++ai)
#pragma unroll
            for (int m = 0; m < 4; ++m) { const int rl = ai * HALF + wr * 64 + m * 16 + fr;
                if (rl < u.nvalid) {
#pragma unroll
                    for (int bj = 0; bj < 2; ++bj) NT_STORE(u32x2, (yb + (size_t)rl * D + col0 + bj * HALF), (pack8_fp8(acc[ai][bj][m][0] * WINV + b[bj][0], acc[ai][bj][m][1] * WINV + b[bj][1]))); } }
        asm volatile("" :: "v"(b[0][0]), "v"(b[0][1]), "v"(b[1][0]), "v"(b[1][1]));
    }
};
}

struct Args { const float* in[19]; float* out; unsigned char* ws; int ph_lo, ph_hi; };
struct Frame {
    LAS unsigned char* lds; volatile LAS unsigned* MISC; unsigned* ctl;
    int tid, lane, wave, G, bx;
    const float *x, *norm_mix, *w_in, *conv_w, *w_out_conv, *q_norm, *k_norm, *rpb, *w_out_attn, *w_o, *norm_ffn, *w_router, *b_router, *w_gate, *b_gate, *w_up, *b_up, *w_down, *b_down;
    float* out; unsigned char* ws;
};

__device__ __forceinline__ float wave_sum(float v) {
#pragma unroll
    for (int o = 1; o < 64; o <<= 1) v += __shfl_xor(v, o);
    return v;
}

__device__ __forceinline__ s16x4 tr_read(const LAS unsigned char* p) { return __builtin_bit_cast(s16x4, __builtin_amdgcn_ds_read_tr16_b64_v4i16((LAS s16x4*)p)); }
using pg8::pk_fp8x4;
__device__ __forceinline__ float bf2f(short h) { return __uint_as_float(((unsigned)(unsigned short)h) << 16); }
template <bool FP8>
__device__ __forceinline__ void p0_item(const float* W, int ldw, int k0, int c0a, int c0b  , unsigned char* dst  , int ldd  , const float* ks, float mul, LAS unsigned char* T, int lane) {
    constexpr int RS = 144;
    const int lq = lane >> 4, li = lane & 15, c0 = (li < 8 ? c0a : c0b) + 4 * (li & 7);
    f32x4 v[16];
#pragma unroll
    for (int i = 0; i < 16; ++i) v[i] = *(const f32x4*)(W + (size_t)(k0 + 4 * i + lq) * ldw + c0);
#pragma unroll
    for (int i = 0; i < 16; ++i) { const int k = 4 * i + lq; const float sc = ks ? mul * ks[k0 + k] : mul; const f32x4 y = v[i] * sc;
        u32x2 w; w.x = cvt_pk_bf16(y[0], y[1]); w.y = cvt_pk_bf16(y[2], y[3]); *(LAS u32x2*)(T + k * RS + 8 * li) = w; }
    LDS_WAIT(); asm volatile("" ::: "memory");
    const LAS unsigned char* tb = T + (li >> 2) * RS + (li & 3) * 8;
#pragma unroll
    for (int nb = 0; nb < 4; ++nb) {
        if constexpr (FP8) {
            s16x4 t[4];
#pragma unroll
            for (int j = 0; j < 4; ++j) t[j] = tr_read(tb + (16 * lq + 4 * j) * RS + nb * 32);
            u32x4 o;
            o.x = pk_fp8x4(bf2f(t[0][0]), bf2f(t[0][1]), bf2f(t[0][2]), bf2f(t[0][3])); o.y = pk_fp8x4(bf2f(t[1][0]), bf2f(t[1][1]), bf2f(t[1][2]), bf2f(t[1][3]));
            o.z = pk_fp8x4(bf2f(t[2][0]), bf2f(t[2][1]), bf2f(t[2][2]), bf2f(t[2][3])); o.w = pk_fp8x4(bf2f(t[3][0]), bf2f(t[3][1]), bf2f(t[3][2]), bf2f(t[3][3]));
            *(u32x4*)(dst + (size_t)(16 * nb + li) * ldd + 16 * lq) = o;
        } else {
#pragma unroll
            for (int hf = 0; hf < 2; ++hf) { const int c = lq + 4 * hf;
                const s16x4 lo = tr_read(tb + (8 * c) * RS + nb * 32), hi = tr_read(tb + (8 * c + 4) * RS + nb * 32);
                const bf16x8 o = {lo[0], lo[1], lo[2], lo[3], hi[0], hi[1], hi[2], hi[3]};
                *(bf16x8*)(dst + (size_t)(16 * nb + li) * ldd + 16 * c) = o; }
        }
    }
    LDS_WAIT(); asm volatile("" ::: "memory");
}
__device__ __forceinline__ int inproj_srccol(int n0) {
    const int t = n0 >> 8, bj = (n0 >> 7) & 1, w = (n0 >> 5) & 3;
    if (t < 4) return (bj ? 1024 : 0) + 128 * t + 32 * w;
    if (t < 6) return 512 + 256 * (t - 4) + 128 * bj + 32 * w;
    if (t < 8) return 1536 + (4 * (t - 6) + w) * 64 + 32 * bj;
    if (t < 10) return 2048 + (4 * (t - 8) + w) * 64 + 32 * bj;
    if (t < 12) return 2560 + 256 * (t - 10) + 128 * bj + 32 * w;
    return (bj ? 4096 : 3072) + 128 * (t - 12) + 32 * w;
}
__device__ __forceinline__ void p0_prologue(Frame& F) {
    LAS unsigned char* T = F.lds + F.wave * 9216;
    const int gw = F.bx * NWAVES + F.wave, NGW = F.G * NWAVES, lane = F.lane;
    unsigned char* Win = F.ws + WS_WIN; unsigned char* Wca = F.ws + WS_WCA; unsigned char* Wo = F.ws + WS_WO;
    constexpr int I_IN = 16 * 80, I_CA = 2 * 8 * 16, I_O = 16 * 16;
    constexpr int NITEMS = I_IN + I_CA + I_O;
    for (int it = gw; it < NITEMS; it += NGW) {
        int r = it;
        if (r < I_IN) { const int kb = r / 80, nb = r % 80; p0_item<false>(F.w_in, PROJW, 64 * kb, inproj_srccol(64 * nb), inproj_srccol(64 * nb + 32), Win + ((size_t)(64 * nb) * D + 64 * kb) * 2, D * 2, nullptr, 1.f, T, lane); continue; } r -= I_IN;
        if (r < I_CA) { const int s = r / 128, q = r % 128, kb = q / 16, nb = q % 16; p0_item<false>(s ? F.w_out_attn : F.w_out_conv, D, 64 * kb, 64 * nb, 64 * nb + 32, Wca + ((size_t)(64 * nb) * D + 512 * s + 64 * kb) * 2, D * 2, nullptr, 1.f, T, lane); continue; } r -= I_CA;
        { const int kb = r / 16, nb = r % 16; p0_item<false>(F.w_o, D, 64 * kb, 64 * nb, 64 * nb + 32, Wo + ((size_t)(64 * nb) * D + 64 * kb) * 2, D * 2, nullptr, 1.f, T, lane); }
    }
    { bf16_t* wh = (bf16_t*)(F.ws + WS_WRH); bf16_t* wl = (bf16_t*)(F.ws + WS_WRL);
      for (int i = F.bx * NTHREADS + F.tid; i < NE * D; i += F.G * NTHREADS) { const int e = i >> 10, k = i & 1023; const float v = F.w_router[k * NE + e] * F.norm_ffn[k];
          const unsigned h = cvt_pk_bf16(v, 0.f) & 0xffffu; const float lo = v - __uint_as_float(h << 16); wh[i] = (bf16_t)h; wl[i] = (bf16_t)(cvt_pk_bf16(lo, 0.f) & 0xffffu); } }
    bf16_t* Hb = (bf16_t*)F.out;
    for (int m = gw; m < M; m += NGW) {
        const f32x4* xr = (const f32x4*)(F.x + (size_t)m * D) + lane; f32x4 v[4]; float s = 0.f;
#pragma unroll
        for (int j = 0; j < 4; ++j) { v[j] = xr[64 * j]; s += (v[j][0] * v[j][0] + v[j][1] * v[j][1]) + (v[j][2] * v[j][2] + v[j][3] * v[j][3]); }
        const float rstd = 1.0f / sqrtf(wave_sum(s) * (1.f / D) + NORM_EPS);
        unsigned long long* o8 = (unsigned long long*)(Hb + (size_t)m * D) + lane;
#pragma unroll
        for (int j = 0; j < 4; ++j) { const f32x4 g = *((const f32x4*)F.norm_mix + lane + 64 * j); const f32x4 y = v[j] * rstd * g;
            o8[64 * j] = (unsigned long long)cvt_pk_bf16(y[0], y[1]) | ((unsigned long long)cvt_pk_bf16(y[2], y[3]) << 32); }
    }
}

constexpr int XITEMS = NE * 16 * 32 + NE * 16 * 16, XITEMS_PER_WAVE = 12;
__device__ __forceinline__ void p0_expert_items(Frame& F, int k0, int k1) {
    LAS unsigned char* T = F.lds + F.wave * 9216;
    const int gw = F.bx * NWAVES + F.wave, NGW = F.G * NWAVES, lane = F.lane;
    unsigned char* Wd = F.ws + WS_WD; unsigned char* Wgu = F.ws + WS_WGU;
    constexpr int I_GU = NE * 16 * 32;
    for (int k = k0; k < k1; ++k) {
        for (int it = gw + k * NGW; it < XITEMS; it += NGW * XITEMS_PER_WAVE) {
            int r = it;
            if (r < I_GU) { const int e = r / 512, q = r % 512, kb = q / 32, nb = q % 32, n0 = 64 * nb, pn = n0 >> 8, bj = (n0 >> 7) & 1, c64 = n0 & 127;
                p0_item<true>((bj ? F.w_up : F.w_gate) + (size_t)e * D * FF, FF, 64 * kb, 128 * pn + c64, 128 * pn + c64 + 32, Wgu + ((size_t)e * 2048 + n0) * D + 64 * kb, D, F.norm_ffn, WSCALE, T, lane); }
            else { r -= I_GU; const int e = r / 256, q = r % 256, kb = q / 16, nb = q % 16;
                p0_item<true>(F.w_down + (size_t)e * FF * D, D, 64 * kb, 64 * nb, 64 * nb + 32, Wd + ((size_t)e * D + 64 * nb) * FF + 64 * kb, FF, nullptr, WSCALE, T, lane); }
        }
    }
}

__device__ __forceinline__ void p2_conv(Frame& F) {
    const bf16_t* U = (const bf16_t*)(F.ws + WS_U); const bf16_t* Bg = (const bf16_t*)(F.ws + WS_BG); bf16_t* za = (bf16_t*)F.out + (size_t)M * D;
    const int c8 = (F.tid & 63) * 8;
    const f32x4 w00 = *(const f32x4*)(F.conv_w + c8), w01 = *(const f32x4*)(F.conv_w + c8 + 4), w10 = *(const f32x4*)(F.conv_w + CONVW + c8), w11 = *(const f32x4*)(F.conv_w + CONVW + c8 + 4),
                w20 = *(const f32x4*)(F.conv_w + 2 * CONVW + c8), w21 = *(const f32x4*)(F.conv_w + 2 * CONVW + c8 + 4);
    const int stride = F.G * NTHREADS;
    for (int it0 = F.bx * NTHREADS + F.tid; it0 < M * 64; it0 += 4 * stride) {
        u32x4 u0[4], um[4], up[4], bb[4];
#pragma unroll
        for (int j = 0; j < 4; ++j) { const int it = it0 + j * stride; const bool ok = it < M * 64; const int t = ok ? it >> 6 : 0, sq = t & (SEQ - 1);
            const u32x4 z4 = {0u, 0u, 0u, 0u};
            u0[j] = *(const u32x4*)(U + (size_t)t * CONVW + c8); um[j] = sq > 0 ? *(const u32x4*)(U + (size_t)(t - 1) * CONVW + c8) : z4; up[j] = sq < SEQ - 1 ? *(const u32x4*)(U + (size_t)(t + 1) * CONVW + c8) : z4;
            bb[j] = *(const u32x4*)(Bg + (size_t)t * CONVW + c8); }
#pragma unroll
        for (int j = 0; j < 4; ++j) { const int it = it0 + j * stride; if (it < M * 64) { const int t = it >> 6;
            f32x4 a0, a1, m0, m1, p0, p1, b0, b1; pg8::unpack8(u0[j], a0, a1); pg8::unpack8(um[j], m0, m1); pg8::unpack8(up[j], p0, p1); pg8::unpack8(bb[j], b0, b1);
            const f32x4 z0 = b0 * (w00 * m0 + w10 * a0 + w20 * p0), z1 = b1 * (w01 * m1 + w11 * a1 + w21 * p1);
            *(u32x4*)(za + (size_t)t * D + c8) = pg8::pack8(z0, z1); } }
    }
}
__device__ __forceinline__ void p2_attn(Frame& F) {
    const bf16_t* Q = (const bf16_t*)(F.ws + WS_Q); const bf16_t* Kp = (const bf16_t*)(F.ws + WS_K); const bf16_t* V = (const bf16_t*)(F.ws + WS_V);
    bf16_t* za = (bf16_t*)F.out + (size_t)M * D;
    LAS unsigned char* Ks = F.lds; LAS unsigned char* Vs = F.lds + 65536; LAS float* rpbl = (LAS float*)(F.lds + LDS_X);
    for (int i = F.tid; i < NH * 15 * 31; i += NTHREADS) rpbl[i] = F.rpb[i] * LOG2E;
    const int lane = F.lane, g = lane >> 4, l15 = lane & 15;
    constexpr int NU = NB * NH * 32;
    u32x4 kv[8], vv[8]; bf16x8 qn[2];
#define ATT_LOAD(UN) do { const int cb_ = (UN) & 3, rb_ = ((UN) >> 2) & 7, h_ = ((UN) >> 5) & 7, b_ = (UN) >> 8; const int kr_ = clampi(8 * rb_ - 4, 0, 48), kc_ = clampi(16 * cb_ - 8, 0, 32); \
        _Pragma("unroll") for (int i = 0; i < 8; ++i) { const int cid = F.tid + NTHREADS * i, key = cid >> 3, c = cid & 7; const size_t tok = (size_t)b_ * SEQ + (kr_ + (key >> 5)) * 64 + kc_ + (key & 31); \
            kv[i] = *(const u32x4*)(Kp + tok * ATTW + h_ * HD + c * 8); vv[i] = *(const u32x4*)(V + tok * ATTW + h_ * HD + c * 8); } \
        { const size_t qt_ = (size_t)b_ * SEQ + (8 * rb_ + F.wave) * 64 + 16 * cb_ + l15; qn[0] = *(const bf16x8*)(Q + qt_ * ATTW + h_ * HD + 8 * g); qn[1] = *(const bf16x8*)(Q + qt_ * ATTW + h_ * HD + 32 + 8 * g); } } while (0)
    if (F.bx < NU) ATT_LOAD(F.bx);
    for (int un = F.bx; un < NU; un += F.G) {
        const int cbk = un & 3, rb = (un >> 2) & 7, h = (un >> 5) & 7, b = un >> 8;
        const int kr0 = clampi(8 * rb - 4, 0, 48), kc0 = clampi(16 * cbk - 8, 0, 32);
        __syncthreads();
#pragma unroll
        for (int i = 0; i < 8; ++i) { const int cid = F.tid + NTHREADS * i, key = cid >> 3, c = cid & 7;
            *(LAS u32x4*)(Ks + key * 128 + ((c ^ ((key >> 1) & 7)) << 4)) = kv[i]; *(LAS u32x4*)(Vs + key * 128 + ((c ^ (((key >> 1) & 3) << 1)) << 4)) = vv[i]; }
        __syncthreads();
        const int qr = 8 * rb + F.wave, rs = clampi(qr - 4, 0, 56), krs = rs - kr0, qc = 16 * cbk + l15, cs = clampi(qc - 8, 0, 48);
        const size_t qtok = (size_t)b * SEQ + qr * 64 + qc;
        const bf16x8 qf[2] = {qn[0], qn[1]};
        if (un + F.G < NU) ATT_LOAD(un + F.G);
        f32x4 sc[8][2];
#pragma unroll
        for (int jr = 0; jr < 8; ++jr)
#pragma unroll
            for (int f = 0; f < 2; ++f) { const int key = (krs + jr) * 32 + 16 * f + l15; f32x4 a = {0.f, 0.f, 0.f, 0.f};
#pragma unroll
                for (int ks = 0; ks < 2; ++ks) { const bf16x8 kf = *(const LAS bf16x8*)(Ks + key * 128 + (((4 * ks + g) ^ ((key >> 1) & 7)) << 4)); a = __builtin_amdgcn_mfma_f32_16x16x32_bf16(kf, qf[ks], a, 0, 0, 0); }
                sc[jr][f] = a; }
        float mx = -1e30f;
        const LAS float* ab = rpbl + h * 465 + (rs - qr + 7) * 31 + (kc0 + 4 * g - qc + 15);
        const int kd0 = kc0 + 4 * g - cs;
#pragma unroll
        for (int jr = 0; jr < 8; ++jr)
#pragma unroll
            for (int f = 0; f < 2; ++f)
#pragma unroll
                for (int r = 0; r < 4; ++r) { const bool valid = (unsigned)(kd0 + 16 * f + r) < 16u; const float bias = ab[jr * 31 + 16 * f + r];
                    const float sv = valid ? sc[jr][f][r] + bias : -1e30f; sc[jr][f][r] = sv; mx = fmaxf(mx, sv); }
        mx = fmaxf(mx, __shfl_xor(mx, 16)); mx = fmaxf(mx, __shfl_xor(mx, 32));
        float sum = 0.f;
#pragma unroll
        for (int jr = 0; jr < 8; ++jr)
#pragma unroll
            for (int f = 0; f < 2; ++f)
#pragma unroll
                for (int r = 0; r < 4; ++r) { const float p = __builtin_amdgcn_exp2f(sc[jr][f][r] - mx); sc[jr][f][r] = p; sum += p; }
        sum += __shfl_xor(sum, 16); sum += __shfl_xor(sum, 32);
        f32x4 o[4];
#pragma unroll
        for (int db = 0; db < 4; ++db) o[db] = (f32x4){0.f, 0.f, 0.f, 0.f};
        const int q4 = l15 >> 2, p4 = lane & 3;
#pragma unroll
        for (int jr = 0; jr < 8; ++jr) {
            const u32x4 pw = pg8::pack8(sc[jr][0], sc[jr][1]); const bf16x8 pb = __builtin_bit_cast(bf16x8, pw);
            const int key1 = (krs + jr) * 32 + 4 * g + q4, key2 = key1 + 16;
#pragma unroll
            for (int db = 0; db < 4; ++db) { const int ch = 2 * db + (p4 >> 1);
                const s16x4 lo = tr_read(Vs + key1 * 128 + ((ch ^ (((key1 >> 1) & 3) << 1)) << 4) + 8 * (p4 & 1));
                const s16x4 hi = tr_read(Vs + key2 * 128 + ((ch ^ (((key2 >> 1) & 3) << 1)) << 4) + 8 * (p4 & 1));
                const bf16x8 vf = {lo[0], lo[1], lo[2], lo[3], hi[0], hi[1], hi[2], hi[3]};
                o[db] = __builtin_amdgcn_mfma_f32_16x16x32_bf16(vf, pb, o[db], 0, 0, 0); } }
        const float inv = 1.0f / sum;
#pragma unroll
        for (int db = 0; db < 4; ++db) { const f32x4 v = o[db] * inv; u32x2 w; w.x = cvt_pk_bf16(v[0], v[1]); w.y = cvt_pk_bf16(v[2], v[3]);
            *(u32x2*)(za + qtok * D + 512 + h * HD + 16 * db + 4 * g) = w; }
    }
    __syncthreads();
}

__device__ __forceinline__ void p5_router(Frame& F) {
    constexpr int RS = 2064;
    LAS unsigned char* Th = F.lds; LAS unsigned char* Tl = F.lds + 32 * RS;
    LAS float* lg = (LAS float*)(F.lds + LDS_X + F.wave * 2112);
    LAS unsigned* lcnt = (LAS unsigned*)(F.lds + LDS_CNT); LAS unsigned* lbase = lcnt + 32;
    const bf16_t* wh = (const bf16_t*)(F.ws + WS_WRH); const bf16_t* wl = (const bf16_t*)(F.ws + WS_WRL);
    for (int i = F.tid; i < 32 * 128; i += NTHREADS) { const int e = i >> 7, c = i & 127; *(LAS u32x4*)(Th + e * RS + c * 16) = *(const u32x4*)(wh + e * D + c * 8); *(LAS u32x4*)(Tl + e * RS + c * 16) = *(const u32x4*)(wl + e * D + c * 8); }
    const int lane = F.lane, g = lane >> 4, l15 = lane & 15;
    unsigned* rowtok = (unsigned*)(F.ws + WS_ROWTOK); unsigned* tokpos = (unsigned*)(F.ws + WS_TOKPOS); float* tokgate = (float*)(F.ws + WS_TOKGATE); float* rstd2 = (float*)(F.ws + WS_RSTD2);
    for (int ch = F.bx; ch < M / 128; ch += F.G) {
        if (F.tid < 32) lcnt[F.tid] = 0u;
        __syncthreads();
        const int t0 = ch * 128 + F.wave * 16;
        f32x4 a0 = {0.f, 0.f, 0.f, 0.f}, a1 = {0.f, 0.f, 0.f, 0.f}; float ssq = 0.f;
        const bf16_t* xp = (const bf16_t*)(F.ws + WS_X1) + (size_t)(t0 + l15) * D + 8 * g;
#pragma unroll 8
        for (int s = 0; s < 32; ++s) {
            const u32x4 xw = *(const u32x4*)(xp + 32 * s); f32x4 v0, v1; pg8::unpack8(xw, v0, v1);
            ssq += (v0[0] * v0[0] + v0[1] * v0[1]) + (v0[2] * v0[2] + v0[3] * v0[3]) + (v1[0] * v1[0] + v1[1] * v1[1]) + (v1[2] * v1[2] + v1[3] * v1[3]);
            const bf16x8 xh = __builtin_bit_cast(bf16x8, xw);
            const int ko = (32 * s + 8 * g) * 2;
            const bf16x8 bh0 = *(const LAS bf16x8*)(Th + l15 * RS + ko), bh1 = *(const LAS bf16x8*)(Th + (16 + l15) * RS + ko), bl0 = *(const LAS bf16x8*)(Tl + l15 * RS + ko), bl1 = *(const LAS bf16x8*)(Tl + (16 + l15) * RS + ko);
            a0 = __builtin_amdgcn_mfma_f32_16x16x32_bf16(xh, bh0, a0, 0, 0, 0); a0 = __builtin_amdgcn_mfma_f32_16x16x32_bf16(xh, bl0, a0, 0, 0, 0);
            a1 = __builtin_amdgcn_mfma_f32_16x16x32_bf16(xh, bh1, a1, 0, 0, 0); a1 = __builtin_amdgcn_mfma_f32_16x16x32_bf16(xh, bl1, a1, 0, 0, 0);
        }
        ssq += __shfl_xor(ssq, 16); ssq += __shfl_xor(ssq, 32);
        const float rstd = 1.0f / sqrtf(ssq * (1.f / D) + NORM_EPS);
        { unsigned char* x8 = F.ws + WS_XB + (size_t)(t0 + l15) * D + 8 * g;
#pragma unroll 1
          for (int s0 = 0; s0 < 32; s0 += 16) { u32x4 xw[16];
#pragma unroll
              for (int j = 0; j < 16; ++j) xw[j] = *(const u32x4*)(xp + 32 * (s0 + j));
#pragma unroll
              for (int j = 0; j < 16; ++j) { f32x4 v0, v1; pg8::unpack8(xw[j], v0, v1); *(u32x2*)(x8 + 32 * (s0 + j)) = pg8::pack8_fp8(v0 * rstd, v1 * rstd); } } }
        const float br0 = F.b_router[l15], br1 = F.b_router[16 + l15];
#pragma unroll
        for (int r = 0; r < 4; ++r) { const float rsr = __shfl(rstd, 4 * g + r); lg[(4 * g + r) * 33 + l15] = a0[r] * rsr + br0; lg[(4 * g + r) * 33 + 16 + l15] = a1[r] * rsr + br1; }
        LDS_WAIT(); asm volatile("" ::: "memory");
        int sel_e[4] = {0, 0, 0, 0}; float sel_g[4] = {0.f, 0.f, 0.f, 0.f}; unsigned lpos[4] = {0u, 0u, 0u, 0u};
        if (lane < 16) {
            float v[32];
#pragma unroll
            for (int e = 0; e < 32; ++e) v[e] = lg[lane * 33 + e];
            float tv[4];
#pragma unroll
            for (int k = 0; k < 4; ++k) { float best = -3.0e38f; int bi = 0;
#pragma unroll
                for (int e = 0; e < 32; ++e) { if (v[e] > best) { best = v[e]; bi = e; } }
#pragma unroll
                for (int e = 0; e < 32; ++e) { if (e == bi) v[e] = -3.0e38f; }
                tv[k] = best; sel_e[k] = bi; }
            float den = 0.f;
#pragma unroll
            for (int k = 0; k < 4; ++k) { sel_g[k] = __builtin_amdgcn_exp2f((tv[k] - tv[0]) * LOG2E); den += sel_g[k]; }
            const float idn = 1.0f / den;
#pragma unroll
            for (int k = 0; k < 4; ++k) { sel_g[k] *= idn; lpos[k] = __hip_atomic_fetch_add(lcnt + sel_e[k], 1u, __ATOMIC_RELAXED, __HIP_MEMORY_SCOPE_WORKGROUP); }
            rstd2[t0 + lane] = rstd;
        }
        __syncthreads();
        if (F.tid < 32) lbase[F.tid] = __hip_atomic_fetch_add(F.ctl + CW_CNT + 64 * F.tid, lcnt[F.tid], RLX_AGENT);
        __syncthreads();
        if (lane < 16) { const int tok = t0 + lane;
#pragma unroll
            for (int k = 0; k < 4; ++k) { const unsigned pos = lbase[sel_e[k]] + lpos[k]; rowtok[(size_t)sel_e[k] * CAP + pos] = (unsigned)tok; tokpos[tok * 4 + k] = ((unsigned)sel_e[k] << 20) | pos; tokgate[tok * 4 + k] = sel_g[k]; } }
        __syncthreads();
    }
}
__device__ __forceinline__ void moe_tables(Frame& F, LAS int* tab) {
    if (F.tid == 0) { int ts = 0, rs = 0;
        for (int e = 0; e < NE; ++e) { const int c = (int)__hip_atomic_load(F.ctl + CW_CNT + 64 * e, RLX_AGENT); tab[e] = ts; tab[40 + e] = c; tab[80 + e] = rs; ts += (c + 255) >> 8; rs += c; }
        tab[32] = ts; tab[112] = rs; }
    __syncthreads();
}
__device__ __forceinline__ void p8_combine(Frame& F, const LAS int* tab) {
    const u32x4* tokpos = (const u32x4*)(F.ws + WS_TOKPOS); const f32x4* tokgate = (const f32x4*)(F.ws + WS_TOKGATE);
    const unsigned char* Y = F.ws + WS_Y; const bf16_t* X1 = (const bf16_t*)(F.ws + WS_X1);
    const int gw = F.bx * NWAVES + F.wave, NGW = F.G * NWAVES, lane = F.lane;
    int t = gw; if (t >= M) return;
    u32x4 tp = tokpos[t]; f32x4 tg = tokgate[t];
    for (; t < M; t += NGW) {
        const int tn = (t + NGW < M) ? t + NGW : t;
        const u32x4 tpn = tokpos[tn]; const f32x4 tgn = tokgate[tn];
        u32x4 yw[4];
#pragma unroll
        for (int k = 0; k < 4; ++k) { const int e = tp[k] >> 20, pos = tp[k] & 0xfffff; const int row = tab[80 + e] + pos; yw[k] = *(const u32x4*)(Y + (size_t)row * D + 16 * lane); }
        const u32x4 xa = *(const u32x4*)(X1 + (size_t)t * D + 16 * lane), xb = *(const u32x4*)(X1 + (size_t)t * D + 16 * lane + 8);
        f32x4 o[4]; pg8::unpack8(xa, o[0], o[1]); pg8::unpack8(xb, o[2], o[3]);
#pragma unroll
        for (int k = 0; k < 4; ++k) { const float gk = tg[k];
#pragma unroll
            for (int q = 0; q < 4; ++q) { const f32x2 lo = __builtin_amdgcn_cvt_pk_f32_fp8((int)yw[k][q], false), hi = __builtin_amdgcn_cvt_pk_f32_fp8((int)yw[k][q], true);
                o[q][0] += gk * lo[0]; o[q][1] += gk * lo[1]; o[q][2] += gk * hi[0]; o[q][3] += gk * hi[1]; } }
        float* op = F.out + (size_t)t * D + 16 * lane;
#pragma unroll
        for (int q = 0; q < 4; ++q) *(f32x4*)(op + 4 * q) = o[q];
        tp = tpn; tg = tgn;
    }
}

constexpr int N_PHASES = 9;
#ifndef XPRE
#define XPRE 3
#endif
__global__ void __launch_bounds__(NTHREADS, 2) mk_fwd(Args args) {
    extern __shared__ __attribute__((aligned(16))) unsigned char lds_raw[];
    Frame F;
    F.lds = (LAS unsigned char*)lds_raw; F.MISC = (volatile LAS unsigned*)(F.lds + LDS_MISC);
    F.tid = threadIdx.x; F.lane = F.tid & 63; F.wave = __builtin_amdgcn_readfirstlane(F.tid >> 6); F.G = gridDim.x; F.bx = blockIdx.x;
    F.ws = args.ws; F.ctl = (unsigned*)(args.ws + WS_CTL); F.out = args.out;
    F.x = args.in[0]; F.norm_mix = args.in[1]; F.w_in = args.in[2]; F.conv_w = args.in[3]; F.w_out_conv = args.in[4]; F.q_norm = args.in[5]; F.k_norm = args.in[6]; F.rpb = args.in[7];
    F.w_out_attn = args.in[8]; F.w_o = args.in[9]; F.norm_ffn = args.in[10]; F.w_router = args.in[11]; F.b_router = args.in[12]; F.w_gate = args.in[13]; F.b_gate = args.in[14];
    F.w_up = args.in[15]; F.b_up = args.in[16]; F.w_down = args.in[17]; F.b_down = args.in[18];
    if (F.tid < 64) F.MISC[F.tid] = 0u;
    __syncthreads();
    XcdBarrier bar; bar.bar = F.ctl + CW_BAR; bar.x = 0; bar.st = nullptr;
#if !MK_MULTI
    bar = xcd_barrier_post(F.ctl + CW_BAR, F.MISC + 8);
#define GRID_BAR() xcd_barrier(bar)
#else
#define GRID_BAR() do {} while (0)
#endif
    const int lo = args.ph_lo, hi = args.ph_hi;
#define IN(k) (lo <= (k) && (k) < hi)
#define SEAM(k) do { if (IN(k) && IN((k) + 1)) GRID_BAR(); } while (0)
#ifndef PROBE_NOEPI
#define PROBE_NOEPI 0
#endif
#define NOEPI_ON(k) ((PROBE_NOEPI >> (k)) & 1)
#define REPS(k) (1 + ((PROBE_REP >> (k)) & 1))
#define REP_BEGIN(k) _Pragma("unroll") for (int rep_##k = 0; rep_##k < REPS(k); ++rep_##k) { if (rep_##k > 0) GRID_BAR();
#define REP_END }
    bf16_t* Hb = (bf16_t*)F.out; bf16_t* za = (bf16_t*)F.out + (size_t)M * D;
    LAS int* tab = (LAS int*)(F.lds + LDS_TAB);

    if (IN(0)) { REP_BEGIN(0) p0_prologue(F); REP_END SEAM(0); }
    if (IN(1)) {
        pg8::DenseOrder S; S.init(Hb, F.ws + WS_WIN, M, PROJW, D * 2, F.G, F.bx);
        pg8::EpiInProj E{(bf16_t*)(F.ws + WS_U), (bf16_t*)(F.ws + WS_BG), (bf16_t*)(F.ws + WS_Q), (bf16_t*)(F.ws + WS_K), (bf16_t*)(F.ws + WS_V), (bf16_t*)(F.ws + WS_R), (bf16_t*)(F.ws + WS_SB), F.q_norm, F.k_norm};
        const int npre = ((F.bx >> 3) & 3) * XPRE;
        p0_expert_items(F, 0, npre); __syncthreads();
        if constexpr (NOEPI_ON(1)) { pg8::gemm_phase<pg8::EpiInProj, pg8::DenseOrder, false, true, false, true>(F.lds, D * 2, S, E); GRID_BAR(); }
        REP_BEGIN(1) pg8::gemm_phase<pg8::EpiInProj, pg8::DenseOrder, false, true, false>(F.lds, D * 2, S, E); REP_END
        p0_expert_items(F, npre, XITEMS_PER_WAVE);
        SEAM(1);
    }
    if (IN(2)) { REP_BEGIN(2) REP_BEGIN(9) p2_conv(F); REP_END REP_BEGIN(10) p2_attn(F); REP_END REP_END SEAM(2); }
    if (IN(3)) {
        pg8::DenseOrder S; S.init(za, F.ws + WS_WCA, M, D, D * 2, F.G, F.bx);
        pg8::EpiMix E{(const bf16_t*)(F.ws + WS_R), (const bf16_t*)(F.ws + WS_SB), (bf16_t*)(F.ws + WS_MIXED)};
        REP_BEGIN(3) pg8::gemm_phase<pg8::EpiMix, pg8::DenseOrder, false, true, false>(F.lds, D * 2, S, E); REP_END
        SEAM(3);
    }
    if (IN(4)) {
        pg8::DenseOrder S; S.init(F.ws + WS_MIXED, F.ws + WS_WO, M, D, D * 2, F.G, F.bx);
        pg8::EpiResid E{F.x, (bf16_t*)(F.ws + WS_X1)};
        REP_BEGIN(4) pg8::gemm_phase<pg8::EpiResid, pg8::DenseOrder, false, true, false>(F.lds, D * 2, S, E); REP_END
        SEAM(4);
    }
    if (IN(5)) { p5_router(F); SEAM(5); }
    if (IN(6)) {
        moe_tables(F, tab);
        const int ntiles = tab[32];
        pg8::MoeOrder S; S.init(F.ws + WS_XB, F.ws + WS_WGU, (const unsigned*)(F.ws + WS_ROWTOK), tab, 0, ntiles, 2 * FF, D, F.G, F.bx, true);
        pg8::EpiSwiglu E{F.b_gate, F.b_up, F.ws + WS_ACT};
        if constexpr (NOEPI_ON(6)) { pg8::gemm_phase<pg8::EpiSwiglu, pg8::MoeOrder, true, true, true, true>(F.lds, D, S, E); GRID_BAR(); }
        REP_BEGIN(6) pg8::gemm_phase<pg8::EpiSwiglu, pg8::MoeOrder, true, true, true>(F.lds, D, S, E); REP_END
        SEAM(6);
    }
    if (IN(7) || IN(8)) {
        moe_tables(F, tab);
        const int ntiles = tab[32];
        if (IN(7)) {
            pg8::EpiDown E{F.b_down, F.ws + WS_Y};
            pg8::MoeOrder S; S.init(F.ws + WS_ACT, F.ws + WS_WD, nullptr, tab, 0, ntiles, D, FF, F.G, F.bx, false);
            if constexpr (NOEPI_ON(7)) { pg8::gemm_phase<pg8::EpiDown, pg8::MoeOrder, false, true, true, true>(F.lds, FF, S, E); GRID_BAR(); }
            REP_BEGIN(7) pg8::gemm_phase<pg8::EpiDown, pg8::MoeOrder, false, true, true>(F.lds, FF, S, E); REP_END
            SEAM(7);
        }
        if (IN(8)) p8_combine(F, tab);
    }
}

extern "C" void kernel_launch(void* const* d_in, const int* in_sizes, int n_in, void* d_out, int out_size, void* d_ws, size_t ws_size, hipStream_t stream) {
    static int grid = 0;
    if (grid == 0) {
        if (n_in != 19 || out_size != M * D || ws_size < WS_END) { fprintf(stderr, "kernel_launch: unexpected shapes / workspace (%zu < %zu)\n", ws_size, (size_t)WS_END); grid = -1; return; }
        if (hipFuncSetAttribute((const void*)mk_fwd, hipFuncAttributeMaxDynamicSharedMemorySize, LDS_BYTES) != hipSuccess) { fprintf(stderr, "kernel_launch: hipFuncSetAttribute failed\n"); grid = -1; return; }
        int dev = 0, cus = 0, per_cu = 0;
        (void)hipGetDevice(&dev); (void)hipDeviceGetAttribute(&cus, hipDeviceAttributeMultiprocessorCount, dev);
        (void)hipOccupancyMaxActiveBlocksPerMultiprocessor(&per_cu, (const void*)mk_fwd, NTHREADS, LDS_BYTES);
        (void)hipGetLastError();
        grid = cus > 0 ? cus : 256;
    }
    if (grid < 0) return;
    (void)hipMemsetAsync((char*)d_ws + WS_CTL, 0, CTL_ZERO_BYTES, stream);
    Args a{};
    for (int i = 0; i < 19; ++i) a.in[i] = (const float*)d_in[i];
    a.out = (float*)d_out; a.ws = (unsigned char*)d_ws;
#if MK_MULTI
    for (int p = 0; p < N_PHASES; ++p) { a.ph_lo = p; a.ph_hi = p + 1; hipLaunchKernelGGL(mk_fwd, dim3(grid), dim3(NTHREADS), LDS_BYTES, stream, a); }
#else
    a.ph_lo = 0; a.ph_hi = N_PHASES;
    hipLaunchKernelGGL(mk_fwd, dim3(grid), dim3(NTHREADS), LDS_BYTES, stream, a);
#endif
}
```

```cpp
#include <hip/hip_runtime.h>
#include <cstdio>
#include <cstdint>

#ifndef MK_MULTI
#define MK_MULTI 0
#endif

#ifndef PROBE_REP
#define PROBE_REP 0
#endif
#ifndef NT_P0X
#define NT_P0X 1
#endif
#ifndef NT_P8
#define NT_P8 0
#endif
#ifndef NT_EPI
#define NT_EPI 0
#endif
#if NT_P0X
#define LD_P0X(p) __builtin_nontemporal_load(p)
#else
#define LD_P0X(p) (*(p))
#endif
#if NT_P8
#define LD_P8(p) __builtin_nontemporal_load(p)
#else
#define LD_P8(p) (*(p))
#endif
#ifndef NT_P8ST
#define NT_P8ST 0
#endif
#if NT_P8ST
#define ST_P8(v, p) __builtin_nontemporal_store(v, p)
#else
#define ST_P8(v, p) (*(p) = (v))
#endif
#ifndef NT_P4X
#define NT_P4X 0
#endif
#if NT_P4X
#define LD_P4X(p) __builtin_nontemporal_load(p)
#else
#define LD_P4X(p) (*(p))
#endif
#ifndef NT_XW
#define NT_XW 1
#endif
#ifndef NT_GATE
#define NT_GATE 1
#endif
#if NT_XW
#define ST_XW(v, p) __builtin_nontemporal_store(v, p)
#else
#define ST_XW(v, p) (*(p) = (v))
#endif
#if NT_GATE
#define ST_GATE(v, p) __builtin_nontemporal_store(v, p)
#else
#define ST_GATE(v, p) (*(p) = (v))
#endif
#if NT_EPI
#define LD_EPI(p) __builtin_nontemporal_load(p)
#else
#define LD_EPI(p) (*(p))
#endif
#define LAS __attribute__((address_space(3)))
#define GAS __attribute__((address_space(1)))
typedef unsigned short bf16_t;
typedef short bf16x8 __attribute__((ext_vector_type(8)));
typedef short s16x4 __attribute__((ext_vector_type(4)));
typedef float f32x4 __attribute__((ext_vector_type(4)));
typedef float f32x2 __attribute__((ext_vector_type(2)));
typedef unsigned u32x4 __attribute__((ext_vector_type(4)));
typedef unsigned u32x2 __attribute__((ext_vector_type(2)));

constexpr int D = 1024, NB = 8, SEQ = 4096, M = NB * SEQ;
constexpr int CONVW = 512, NH = 8, HD = 64, ATTW = 512, PROJW = 5120;
constexpr int NE = 32, TOPK = 4, FF = 1024, NASG = M * TOPK, CAP = M;
constexpr float NORM_EPS = 1e-6f, LOG2E = 1.4426950408889634f;
constexpr int NTHREADS = 512, NWAVES = 8;

constexpr size_t MiB = 1u << 20;
constexpr size_t WS_CTL = 0, CTL_ZERO_BYTES = 64 * 1024;
constexpr size_t WS_WRH = 1 * MiB, WS_WRL = 1 * MiB + 65536;
constexpr size_t WS_ROWTOK = 2 * MiB;
constexpr size_t WS_TOKPOS = 6 * MiB, WS_TOKGATE = 6 * MiB + 512 * 1024;
constexpr size_t WS_RSTD2 = 7 * MiB;
constexpr size_t WS_WIN = 8 * MiB, WS_WCA = 18 * MiB, WS_WO = 20 * MiB;
constexpr size_t WS_WD = 24 * MiB, WS_WGU = 56 * MiB;
constexpr size_t WS_XB = 120 * MiB;
constexpr size_t WS_ACT = 152 * MiB;
constexpr size_t WS_Y = 281 * MiB;
constexpr size_t WS_X1 = 409 * MiB;
constexpr size_t WS_END = WS_X1 + (size_t)M * D * 2;
static_assert(WS_ACT + (size_t)(NASG + 256) * FF <= WS_Y && WS_Y + (size_t)NASG * D <= WS_X1, "ws map");
constexpr size_t WS_U = 152 * MiB, WS_BG = 184 * MiB, WS_Q = 216 * MiB, WS_K = 248 * MiB, WS_V = 280 * MiB, WS_R = 312 * MiB, WS_SB = 376 * MiB;
constexpr size_t WS_MIXED = 152 * MiB;
constexpr float WSCALE = 64.0f, WINV = 1.0f / 64.0f;
constexpr int CW_TMO = 0, CW_CNT = 64  , CW_BAR = 4096;

constexpr int RING_BYTES = 131072;
constexpr int LDS_X = 132096;
constexpr int LDS_TAB = 148992;
constexpr int LDS_CNT = 149504;
constexpr int LDS_MISC = 149760;
constexpr int LDS_BYTES = 163840;
static_assert(LDS_MISC + 256 <= LDS_BYTES, "lds map");

#define RLX_AGENT __ATOMIC_RELAXED, __HIP_MEMORY_SCOPE_AGENT
#define LDS_WAIT() asm volatile("s_waitcnt lgkmcnt(0)" ::: "memory")
#define VM_WAIT() asm volatile("s_waitcnt vmcnt(0)" ::: "memory")
__device__ __forceinline__ unsigned cvt_pk_bf16(float lo, float hi) { unsigned r; asm volatile("v_cvt_pk_bf16_f32 %0, %1, %2" : "=v"(r) : "v"(lo), "v"(hi)); return r; }
__device__ __forceinline__ float bf_lo(unsigned w) { return __uint_as_float(w << 16); }
__device__ __forceinline__ float bf_hi(unsigned w) { return __uint_as_float(w & 0xffff0000u); }
__device__ __forceinline__ int clampi(int v, int lo, int hi) { return v < lo ? lo : (v > hi ? hi : v); }

#ifndef PROBE_SW
#define PROBE_SW 0
#endif
#ifndef SW_MULT
#define SW_MULT 8
#endif
#ifndef SW_BLOCK
#define SW_BLOCK 0
#endif
#define SW_LDS_OFF (149760 + 128)
#if PROBE_SW
#define SW_BEGIN(id) unsigned long long sw_t0_##id = 0ull; if (((PROBE_SW) == (id) || (id) == 30 || (id) == 40) && threadIdx.x == 0) sw_t0_##id = __builtin_amdgcn_s_memrealtime();
#define SW_END(id) do { if ((PROBE_SW) == (id) && threadIdx.x == 0) { volatile LAS unsigned long long* a_ = (volatile LAS unsigned long long*)(size_t)(SW_LDS_OFF); *a_ = *a_ + (__builtin_amdgcn_s_memrealtime() - sw_t0_##id); } } while (0)
#else
#define SW_BEGIN(id)
#define SW_END(id) do {} while (0)
#endif
#if PROBE_SW
#define SW_END_ID(var, id) do { if ((PROBE_SW) == (id) && threadIdx.x == 0) { volatile LAS unsigned long long* a_ = (volatile LAS unsigned long long*)(size_t)(SW_LDS_OFF); *a_ = *a_ + (__builtin_amdgcn_s_memrealtime() - sw_t0_##var); } } while (0)
#else
#define SW_END_ID(var, id) do {} while (0)
#endif
#define XB_TMO      128
#define XB_XCNT(j)  (256  + 64 * (j))
#define XB_XSUB(j)  (1280 + 64 * (j))
#define XB_XGEN(j)  (2304 + 64 * (j))
#define XB_TOP      3328
#define XB_TOPGEN   3392
#define XCD_BAR_WORDS 3456
#define XB_SPIN_CAP (1u << 18)
__device__ __forceinline__ unsigned xb_ld(unsigned* p)              { return __hip_atomic_load(p, __ATOMIC_RELAXED, __HIP_MEMORY_SCOPE_AGENT); }
__device__ __forceinline__ unsigned xb_add(unsigned* p, unsigned v) { return __hip_atomic_fetch_add(p, v, __ATOMIC_RELAXED, __HIP_MEMORY_SCOPE_AGENT); }
__device__ __forceinline__ unsigned xb_xcc_id() { return (unsigned)__builtin_amdgcn_s_getreg((3 << 11) | 20) & 0xFu; }
#define XB_SPIN(cond, bar) do { unsigned _sp = 0; while (cond) { __builtin_amdgcn_s_sleep(1); \
    if ((++_sp & 255u) == 0u) { if (xb_ld(&(bar)[XB_TMO])) break; if (_sp > XB_SPIN_CAP) { atomicAdd(&(bar)[XB_TMO], 1u); break; } } } } while (0)
struct XcdBarrier { unsigned* bar; unsigned x; volatile LAS unsigned* st; };
__device__ __forceinline__ XcdBarrier xcd_barrier_post(unsigned* bar, volatile LAS unsigned* st) {
    XcdBarrier b; b.bar = bar; b.x = xb_xcc_id(); b.st = st;
    if (threadIdx.x == 0) (void)xb_add(&bar[XB_XCNT(b.x)], 1u);
    return b;
}
__device__ __forceinline__ void xcd_barrier_complete(unsigned* bar, unsigned x, unsigned& nloc, unsigned& nx) {
    const unsigned G = gridDim.x * gridDim.y * gridDim.z;
    unsigned sum, cnt, mine, sp = 0u;
    for (;;) {
        sum = 0u; cnt = 0u; mine = 0u;
#pragma unroll
        for (unsigned j = 0; j < 16; ++j) { const unsigned c = xb_ld(&bar[XB_XCNT(j)]); sum += c; cnt += (c > 0u) ? 1u : 0u; mine = (j == x) ? c : mine; }
        if (sum == G) break;
        __builtin_amdgcn_s_sleep(1);
        if ((++sp & 255u) == 0u) { if (xb_ld(&bar[XB_TMO])) break; if (sp > XB_SPIN_CAP) { atomicAdd(&bar[XB_TMO], 1u); break; } }
    }
    nloc = mine > 0u ? mine : 1u; nx = cnt > 0u ? cnt : 1u;
}
__device__ __forceinline__ void xcd_barrier(const XcdBarrier& b) {
    asm volatile("s_waitcnt vmcnt(0)" ::: "memory");
    __syncthreads();
    if (threadIdx.x == 0) {
        unsigned* bar = b.bar;
        __builtin_amdgcn_s_waitcnt(0);
        unsigned nloc = b.st[0], nx = b.st[1];
        if (nloc == 0u) { xcd_barrier_complete(bar, b.x, nloc, nx); b.st[0] = nloc; b.st[1] = nx; }
        const unsigned old = xb_add(&bar[XB_XSUB(b.x)], 1u);
        const unsigned gen = old / nloc;
        if (old + 1u == (gen + 1u) * nloc) {
            __builtin_amdgcn_fence(__ATOMIC_RELEASE, "agent");
            asm volatile("s_waitcnt vmcnt(0)" ::: "memory");
            const unsigned og = xb_add(&bar[XB_TOP], 1u);
            const unsigned tg = og / nx;
            if (og + 1u == (tg + 1u) * nx) xb_add(&bar[XB_TOPGEN], 1u);
            else XB_SPIN(xb_ld(&bar[XB_TOPGEN]) == tg, bar);
            __builtin_amdgcn_fence(__ATOMIC_ACQUIRE, "agent");
            xb_add(&bar[XB_XGEN(b.x)], 1u);
            asm volatile("s_waitcnt vmcnt(0)" ::: "memory");
        } else {
            XB_SPIN(xb_ld(&bar[XB_XGEN(b.x)]) == gen, bar);
            __builtin_amdgcn_fence(__ATOMIC_ACQUIRE, "agent");
            asm volatile("s_waitcnt vmcnt(0)" ::: "memory");
        }
    }
    __syncthreads();
}

namespace pg8 {
constexpr int BM = 256, BK = 64, HALF = 128, HTB = HALF * BK * 2, NXCD = 8, WGM = 8;
__host__ __device__ __forceinline__ int lds_byte(int r, int c) { const int st = (r >> 4) * 2 + (c >> 5), rr = r & 15, cc = c & 31, ob = rr * 64 + cc * 2; return st * 1024 + (ob ^ (((ob >> 9) & 1) << 5)); }
__host__ __device__ __forceinline__ void stage_rc(int b, int& R, int& C) { const int st = b / 1024, sb = b % 1024, swz = sb ^ (((sb >> 9) & 1) << 5); R = (st >> 1) * 16 + swz / 64; C = (st & 1) * 32 + (swz % 64) / 2; }
__host__ __device__ __forceinline__ int perm32(int rho) { const int n = rho >> 4, i = rho & 15; return 8 * (i >> 2) + 4 * n + (i & 3); }

struct Unit { int pm, pn, e, nvalid, rowbase, lbase; };

struct DenseOrder {
    const char* A; const char* Bt; int nM, nN, nwg, G, c; size_t tstep;
    __device__ void init(const void* A_, const void* Bt_, int Mr, int N, int KB  , int G_, int c_) { A = (const char*)A_; Bt = (const char*)Bt_; nM = Mr / BM; nN = N / BM; nwg = nM * nN; G = G_; c = c_; tstep = (size_t)BM * KB; }
    __device__ __forceinline__ bool next(int i, Unit& u) const {
        const long L = (long)i * G + c; if (L >= nwg) return false;
        int wgid = (int)L; { const int q = nwg / NXCD, r = nwg % NXCD, xcd = wgid % NXCD, off = wgid / NXCD; wgid = (xcd < r ? xcd * (q + 1) : r * (q + 1) + (xcd - r) * q) + off; }
        const int nig = WGM * nN, gid = wgid / nig, fm = gid * WGM, gsz = (nM - fm) < WGM ? (nM - fm) : WGM;
        u.pm = fm + ((wgid % nig) % gsz); u.pn = (wgid % nig) / gsz; u.e = 0; u.nvalid = BM; u.rowbase = 0; u.lbase = 0; return true;
    }
    __device__ __forceinline__ unsigned a_off(const Unit& u) const { return (unsigned)u.pm * (unsigned)tstep; }
    __device__ __forceinline__ unsigned b_off(const Unit& u) const { return (unsigned)u.pn * (unsigned)tstep; }
    __device__ __forceinline__ unsigned row_tok(const Unit&, int) const { return 0u; }
};

struct MoeOrder {
    const char* A; const char* Bt; const unsigned* rowtok; const LAS int* tab; int tlo, nT, nN, nwg, G, c; size_t tstep, estride, rowbytes; bool gather;
    __device__ void init(const void* A_, const void* Bt_, const unsigned* rowtok_, const LAS int* tab_, int tlo_, int thi_, int N, int KB  , int G_, int c_, bool gather_) {
        A = (const char*)A_; Bt = (const char*)Bt_; rowtok = rowtok_; tab = tab_; tlo = tlo_; nT = thi_ - tlo_; if (nT < 0) nT = 0; nN = N / BM; nwg = nT * nN; G = G_; c = c_;
        tstep = (size_t)BM * KB; estride = (size_t)N * KB; rowbytes = (size_t)KB; gather = gather_; }
    __device__ __forceinline__ bool next(int i, Unit& u) const {
        const long L = (long)i * G + c; if (L >= nwg) return false;
        int wgid = (int)L; { const int q = nwg / NXCD, r = nwg % NXCD, xcd = wgid % NXCD, off = wgid / NXCD; wgid = (xcd < r ? xcd * (q + 1) : r * (q + 1) + (xcd - r) * q) + off; }
        const int nig = WGM * nN, gid = wgid / nig, fm = gid * WGM, gsz = (nT - fm) < WGM ? (nT - fm) : WGM;
        const int gt = tlo + fm + ((wgid % nig) % gsz), pn = (wgid % nig) / gsz;
        const int lane = threadIdx.x & 63;
        const int ts = (lane < 32) ? tab[lane] : 0x7fffffff;
        const unsigned long long mask = __ballot(ts <= gt);
        const int e = __builtin_popcountll(mask) - 1;
        const int j = gt - __builtin_amdgcn_readfirstlane(tab[e]);
        const int cnt = __builtin_amdgcn_readfirstlane(tab[40 + e]), es = __builtin_amdgcn_readfirstlane(tab[80 + e]);
        u.pm = gt; u.pn = pn; u.e = e; const int nv = cnt - 256 * j; u.nvalid = nv > 256 ? 256 : nv; u.rowbase = es + 256 * j; u.lbase = e * CAP + 256 * j; return true;
    }
    __device__ __forceinline__ unsigned a_off(const Unit& u) const { return gather ? 0u : (unsigned)u.rowbase * (unsigned)rowbytes; }
    __device__ __forceinline__ unsigned b_off(const Unit& u) const { return (unsigned)u.e * (unsigned)estride + (unsigned)u.pn * (unsigned)tstep; }
    __device__ __forceinline__ unsigned row_tok(const Unit& u, int r) const { const int rr = r < u.nvalid ? r : 0; return rowtok[u.lbase + rr]; }
};

typedef int v8i __attribute__((ext_vector_type(8))); typedef int v4i __attribute__((ext_vector_type(4)));
__device__ __forceinline__ v8i cat8(const bf16x8 a, const bf16x8 b) { return __builtin_shufflevector(__builtin_bit_cast(v4i, a), __builtin_bit_cast(v4i, b), 0, 1, 2, 3, 4, 5, 6, 7); }
struct FillItem { const float* W; int ldw, k0, c0a; unsigned char* dst; int ldd; const float* ks; };
struct NoFill { static constexpr int NV = 1; static constexpr bool SPLIT = false; __device__ __forceinline__ bool begin(int, FillItem&, f32x4 (&)[1]) const { return false; } __device__ __forceinline__ void finish(const FillItem&, const f32x4 (&)[1]) const {} };
template <class Epi, class Sched, bool GATHER, bool ALIGN_EPI, bool FP8, bool NOEPI = false, bool NOMID = false, class Fill = NoFill>
__device__ __forceinline__ void gemm_phase(LAS unsigned char* lds, const int KB, const Sched& S, const Epi& E, const Fill& FL = Fill()) {
    const int tid = threadIdx.x, wid = __builtin_amdgcn_readfirstlane(tid >> 6), lane = tid & 63, wr = wid >> 2, wc = wid & 3, fr = lane & 15, fq = lane >> 4;
    const int nt = KB / 128;
    int Rst[2], Cst[2]; unsigned voffB[2];
#pragma unroll
    for (int i = 0; i < 2; ++i) { int R, C; stage_rc(tid * 16 + i * 8192, R, C); Rst[i] = R; Cst[i] = C; const int Rb = (R & ~31) + perm32(R & 31); voffB[i] = (unsigned)(Rb * KB + C * 2); }
    const unsigned kstep = 128u;
    const unsigned hstep = (unsigned)HALF * (unsigned)KB;
    const __amdgpu_buffer_rsrc_t rsA = __builtin_amdgcn_make_buffer_rsrc((void*)S.A, 0, 0x7ffffff0, 0x00020000), rsB = __builtin_amdgcn_make_buffer_rsrc((void*)S.Bt, 0, 0x7ffffff0, 0x00020000);
    const unsigned ldsw = (unsigned)wid * 1024u;
    const int aoff = lds_byte(wr * 64 + fr, fq * 8), boff = lds_byte(wc * 32 + fr, fq * 8);
#define PG8_SA(b, h) (((b) * 2 + (h)) * HTB)
#define PG8_SB(b, h) ((4 + (b) * 2 + (h)) * HTB)
#ifndef GLDS_BUF_ALL
#define GLDS_BUF_ALL 1
#endif
#define PG8_GLDS(rs, basep, voff, soff, ldsoff) do { if constexpr (FP8 || GLDS_BUF_ALL) __builtin_amdgcn_raw_ptr_buffer_load_lds(rs, (LAS unsigned*)(lds + (ldsoff)), 16, (int)(voff), (int)(soff), 0, 0); \
        else __builtin_amdgcn_global_load_lds((const unsigned*)((basep) + (size_t)(soff) + (voff)), (LAS unsigned*)(lds + (ldsoff)), 16, 0, 0); } while (0)
#define PG8_STAGE_B(bufoff, soff) do { PG8_GLDS(rsB, S.Bt, voffB[0], soff, (bufoff) + ldsw); PG8_GLDS(rsB, S.Bt, voffB[1], soff, (bufoff) + ldsw + 8192); } while (0)
#define PG8_STAGE_A(bufoff, soff, o0, o1) do { PG8_GLDS(rsA, S.A, o0, soff, (bufoff) + ldsw); PG8_GLDS(rsA, S.A, o1, soff, (bufoff) + ldsw + 8192); } while (0)
#define PG8_LDA(dst, b, h) do { _Pragma("unroll") for (int m = 0; m < 4; ++m) _Pragma("unroll") for (int k = 0; k < 2; ++k) dst[m][k] = *(const LAS bf16x8*)(lds + PG8_SA(b, h) + aoff + m * 2048 + k * 1024); } while (0)
#define PG8_LDB(dst, b, h) do { _Pragma("unroll") for (int n = 0; n < 2; ++n) _Pragma("unroll") for (int k = 0; k < 2; ++k) dst[n][k] = *(const LAS bf16x8*)(lds + PG8_SB(b, h) + boff + n * 2048 + k * 1024); } while (0)
#define PG8_MMA(ai, bj, At, Bt) do { __builtin_amdgcn_s_setprio(1); _Pragma("unroll") for (int m = 0; m < 4; ++m) _Pragma("unroll") for (int n = 0; n < 2; ++n) { \
        if constexpr (FP8) { const v8i b8_ = cat8(Bt[n][0], Bt[n][1]), a8_ = cat8(At[m][0], At[m][1]); asm volatile("v_mfma_f32_16x16x128_f8f6f4 %0, %1, %2, %0" : "+v"(acc[ai][bj][m][n]) : "v"(b8_), "v"(a8_)); } \
        else { _Pragma("unroll") for (int k = 0; k < 2; ++k) acc[ai][bj][m][n] = __builtin_amdgcn_mfma_f32_16x16x32_bf16(Bt[n][k], At[m][k], acc[ai][bj][m][n], 0, 0, 0); } } \
        __builtin_amdgcn_s_setprio(0); } while (0)
#define PG8_WAIT_V(n) asm volatile("s_waitcnt vmcnt(" #n ")" ::: "memory")
#define PG8_WAIT_L(n) asm volatile("s_waitcnt lgkmcnt(" #n ")" ::: "memory")
#define PG8_BAR __builtin_amdgcn_s_barrier()
#define PG8_SCHED __builtin_amdgcn_sched_barrier(0)
    Unit cur, nxt, nn; int ui = 0;
    if (!S.next(0, cur)) return;
    bool has_next = S.next(1, nxt);
    unsigned coff[2][2], noff[2][2];
#pragma unroll
    for (int h = 0; h < 2; ++h)
#pragma unroll
        for (int i = 0; i < 2; ++i) {
            if constexpr (GATHER) { coff[h][i] = S.row_tok(cur, h * HALF + Rst[i]) * (unsigned)KB + (unsigned)Cst[i] * 2u;
                                    noff[h][i] = has_next ? S.row_tok(nxt, h * HALF + Rst[i]) * (unsigned)KB + (unsigned)Cst[i] * 2u : coff[h][i]; }
            else { coff[h][i] = (unsigned)((h * HALF + Rst[i]) * KB + Cst[i] * 2); noff[h][i] = coff[h][i]; }
        }
    f32x4 acc[2][2][4][2];
#pragma unroll
    for (int a = 0; a < 2; ++a)
#pragma unroll
        for (int b = 0; b < 2; ++b)
#pragma unroll
            for (int m = 0; m < 4; ++m)
#pragma unroll
                for (int n = 0; n < 2; ++n) acc[a][b][m][n] = (f32x4){0.f, 0.f, 0.f, 0.f};
    bf16x8 At[4][2], B0[2][2], B1[2][2];
    unsigned cA = S.a_off(cur), cB = S.b_off(cur);
    typename Epi::Pre epre = E.pre(cur, wc, fq);
    PG8_STAGE_B(PG8_SB(0, 0), cB); PG8_STAGE_B(PG8_SB(0, 1), cB + hstep); PG8_STAGE_A(PG8_SA(0, 0), cA, coff[0][0], coff[0][1]); PG8_STAGE_A(PG8_SA(0, 1), cA, coff[1][0], coff[1][1]);
    if (wr == 1) PG8_BAR;
    PG8_WAIT_V(2); PG8_BAR;
    PG8_STAGE_B(PG8_SB(1, 0), cB + kstep); PG8_STAGE_A(PG8_SA(1, 0), cA + kstep, coff[0][0], coff[0][1]); PG8_STAGE_B(PG8_SB(1, 1), cB + hstep + kstep);
    PG8_WAIT_V(6); PG8_BAR;
    for (;;) {
        if constexpr (!GATHER) { if (ui > 0) has_next = S.next(ui + 1, nxt); }
        const unsigned nA = has_next ? S.a_off(nxt) : cA, nB = has_next ? S.b_off(nxt) : cB;
#pragma unroll 1
        for (int t = 0; t < nt; t += 2) {
            const bool last = (t == nt - 2);
            if constexpr (Epi::HAS_MID && !NOMID) { if (t == nt / 2) E.mid(acc, cur, wr, wc, fr, fq); }
            const unsigned a1 = cA + (unsigned)(t + 1) * kstep;
            const unsigned a2 = last ? nA : cA + (unsigned)(t + 2) * kstep, b2 = last ? nB : cB + (unsigned)(t + 2) * kstep;
            const unsigned a3 = a2 + kstep, b3 = b2 + kstep;
            unsigned x00, x01, x10, x11;
            if constexpr (GATHER) { x00 = last ? noff[0][0] : coff[0][0]; x01 = last ? noff[0][1] : coff[0][1]; x10 = last ? noff[1][0] : coff[1][0]; x11 = last ? noff[1][1] : coff[1][1]; }
            else { x00 = coff[0][0]; x01 = coff[0][1]; x10 = coff[1][0]; x11 = coff[1][1]; }
            PG8_LDB(B0, 0, 0); PG8_LDB(B1, 0, 1); PG8_SCHED; PG8_LDA(At, 0, 0); PG8_STAGE_A(PG8_SA(1, 1), a1, coff[1][0], coff[1][1]);
            PG8_WAIT_V(8); PG8_WAIT_L(0); PG8_BAR; PG8_MMA(0, 0, At, B0); PG8_MMA(0, 1, At, B1); PG8_BAR; PG8_SCHED;
            PG8_LDA(At, 0, 1); PG8_STAGE_B(PG8_SB(0, 0), b2); PG8_STAGE_B(PG8_SB(0, 1), b2 + hstep); PG8_STAGE_A(PG8_SA(0, 0), a2, x00, x01);
            PG8_WAIT_V(8); PG8_WAIT_L(0); PG8_BAR; PG8_MMA(1, 0, At, B0); PG8_MMA(1, 1, At, B1); PG8_BAR; PG8_SCHED;
            PG8_LDB(B0, 1, 0); PG8_LDB(B1, 1, 1); PG8_SCHED; PG8_LDA(At, 1, 0); PG8_STAGE_A(PG8_SA(0, 1), a2, x10, x11);
            PG8_WAIT_V(8); PG8_WAIT_L(0); PG8_BAR; PG8_MMA(0, 0, At, B0); PG8_MMA(0, 1, At, B1); PG8_BAR; PG8_SCHED;
            PG8_LDA(At, 1, 1); PG8_STAGE_B(PG8_SB(1, 0), b3); PG8_STAGE_B(PG8_SB(1, 1), b3 + hstep); PG8_STAGE_A(PG8_SA(1, 0), a3, x00, x01);
            PG8_WAIT_V(8); PG8_WAIT_L(0); PG8_BAR; PG8_MMA(1, 0, At, B0); PG8_MMA(1, 1, At, B1); PG8_BAR; PG8_SCHED;
        }
        if constexpr (FP8) asm volatile("s_nop 15\n\ts_nop 15" ::: "memory");
        if constexpr (ALIGN_EPI) { if (wr == 0) PG8_BAR; }
        bool has_nn = false; unsigned pend[2][2] = {{0u, 0u}, {0u, 0u}};
        if constexpr (GATHER) {
            has_nn = has_next && S.next(ui + 2, nn);
            if (has_nn) {
#pragma unroll
                for (int h = 0; h < 2; ++h)
#pragma unroll
                    for (int i = 0; i < 2; ++i) pend[h][i] = S.row_tok(nn, h * HALF + Rst[i]); }
        }
        if constexpr (NOEPI) {
#pragma unroll
            for (int a = 0; a < 2; ++a)
#pragma unroll
                for (int b = 0; b < 2; ++b)
#pragma unroll
                    for (int m = 0; m < 4; ++m) asm volatile("" :: "v"(acc[a][b][m][0]), "v"(acc[a][b][m][1]));
        }
        FillItem fitem_; f32x4 fv_[Fill::NV]; bool fdo_ = false;
        if constexpr (Fill::SPLIT) { E.part(acc, cur, wr, wc, fr, fq, epre, 0, 1); asm volatile("" ::: "memory"); fdo_ = FL.begin(ui, fitem_, fv_); E.part(acc, cur, wr, wc, fr, fq, epre, 1, 2); }
        else if constexpr (!NOEPI) { SW_BEGIN(30) E(acc, cur, wr, wc, fr, fq, epre); if ((PROBE_SW) == Epi::SW_ID) { asm volatile("s_waitcnt vmcnt(0)" ::: "memory"); } SW_END_ID(30, Epi::SW_ID); }
        if (fdo_) FL.finish(fitem_, fv_);
        if (!has_next) break;
#pragma unroll
        for (int a = 0; a < 2; ++a)
#pragma unroll
            for (int b = 0; b < 2; ++b)
#pragma unroll
                for (int m = 0; m < 4; ++m)
#pragma unroll
                    for (int n = 0; n < 2; ++n) acc[a][b][m][n] = (f32x4){0.f, 0.f, 0.f, 0.f};
        cur = nxt; cA = nA; cB = nB; ++ui;
        epre = E.pre(cur, wc, fq);
        if constexpr (GATHER) {
#pragma unroll
            for (int h = 0; h < 2; ++h)
#pragma unroll
                for (int i = 0; i < 2; ++i) { coff[h][i] = noff[h][i]; if (has_nn) noff[h][i] = pend[h][i] * (unsigned)KB + (unsigned)Cst[i] * 2u; }
            nxt = nn; has_next = has_nn;
        }
        if constexpr (ALIGN_EPI) { if (wr == 1) PG8_BAR; }
    }
    PG8_WAIT_V(0);
    if constexpr (!ALIGN_EPI) { if (wr == 0) PG8_BAR; }
    PG8_BAR;
#undef PG8_SA
#undef PG8_SB
#undef PG8_GLDS
#undef PG8_STAGE_A
#undef PG8_STAGE_B
#undef PG8_LDA
#undef PG8_LDB
#undef PG8_MMA
#undef PG8_WAIT_V
#undef PG8_WAIT_L
#undef PG8_BAR
#undef PG8_SCHED
}

typedef f32x4 Acc[2][2][4][2];
#ifndef EPI_NT
#define EPI_NT 0
#endif
#if EPI_NT
#define NT_STORE(T, p, v) __builtin_nontemporal_store((T)(v), (T*)(p))
#else
#define NT_STORE(T, p, v) (*(T*)(p) = (v))
#endif
__device__ __forceinline__ u32x4 pack8(const f32x4 a, const f32x4 b) { u32x4 w; w.x = cvt_pk_bf16(a[0], a[1]); w.y = cvt_pk_bf16(a[2], a[3]); w.z = cvt_pk_bf16(b[0], b[1]); w.w = cvt_pk_bf16(b[2], b[3]); return w; }
__device__ __forceinline__ unsigned pk_fp8x4(float a, float b, float c, float d) { int w = __builtin_amdgcn_cvt_pk_fp8_f32(a, b, 0, false); w = __builtin_amdgcn_cvt_pk_fp8_f32(c, d, w, true); return (unsigned)w; }
__device__ __forceinline__ u32x2 pack8_fp8(const f32x4 a, const f32x4 b) { u32x2 w; w.x = pk_fp8x4(a[0], a[1], a[2], a[3]); w.y = pk_fp8x4(b[0], b[1], b[2], b[3]); return w; }
__device__ __forceinline__ void unpack8(const u32x4 w, f32x4& a, f32x4& b) { a = (f32x4){bf_lo(w.x), bf_hi(w.x), bf_lo(w.y), bf_hi(w.y)}; b = (f32x4){bf_lo(w.z), bf_hi(w.z), bf_lo(w.w), bf_hi(w.w)}; }

struct EpiInProj {
    static constexpr bool HAS_MID = false; static constexpr int SW_ID = 11;
    struct Pre {}; __device__ __forceinline__ Pre pre(const Unit&, int, int) const { return Pre{}; }
    bf16_t *U, *Bg, *Q, *Kk, *V, *R, *SB; const float *qn, *kn;
    __device__ __forceinline__ void operator()(const Acc& acc, const Unit& u, int wr, int wc, int fr, int fq, const Pre& p) const { part(acc, u, wr, wc, fr, fq, p, 0, 2); }
    __device__ __forceinline__ void part(const Acc& acc, const Unit& u, int wr, int wc, int fr, int fq, const Pre&, const int ailo, const int aihi) const {
        const int t = u.pn; const size_t row0 = (size_t)u.pm * BM + wr * 64 + fr; const int cb = wc * 32 + 8 * fq;
        if (t < 4) {
#pragma unroll
            for (int ai = ailo; ai < aihi; ++ai)
#pragma unroll
                for (int m = 0; m < 4; ++m) { const size_t r = row0 + ai * HALF + m * 16;
                    NT_STORE(u32x4, (U + r * CONVW + t * 128 + cb), (pack8(acc[ai][0][m][0] * acc[ai][1][m][0], acc[ai][0][m][1] * acc[ai][1][m][1]))); }
        } else if (t < 6 || t == 10 || t == 11) {
            bf16_t* base = (t < 6) ? Bg + (t - 4) * 256 : V + (t - 10) * 256;
#pragma unroll
            for (int ai = ailo; ai < aihi; ++ai)
#pragma unroll
                for (int m = 0; m < 4; ++m) { const size_t r = row0 + ai * HALF + m * 16;
#pragma unroll
                    for (int bj = 0; bj < 2; ++bj) NT_STORE(u32x4, (base + r * 512 + bj * HALF + cb), (pack8(acc[ai][bj][m][0], acc[ai][bj][m][1]))); }
        } else if (t < 10) {
            const bool isq = t < 8; bf16_t* base = isq ? Q : Kk; const float* gn = isq ? qn : kn; const float sc = isq ? 0.125f * LOG2E : 1.0f;
            const int hh = 4 * (t & 1) + wc;
            f32x4 g[2][2];
#pragma unroll
            for (int bj = 0; bj < 2; ++bj) { g[bj][0] = *(const f32x4*)(gn + 32 * bj + 8 * fq) * sc; g[bj][1] = *(const f32x4*)(gn + 32 * bj + 8 * fq + 4) * sc; }
#pragma unroll
            for (int ai = ailo; ai < aihi; ++ai)
#pragma unroll
                for (int m = 0; m < 4; ++m) { const size_t r = row0 + ai * HALF + m * 16; float ss = 0.f;
#pragma unroll
                    for (int bj = 0; bj < 2; ++bj)
#pragma unroll
                        for (int n = 0; n < 2; ++n) { const f32x4 v = acc[ai][bj][m][n]; ss += (v[0] * v[0] + v[1] * v[1]) + (v[2] * v[2] + v[3] * v[3]); }
                    ss += __shfl_xor(ss, 16); ss += __shfl_xor(ss, 32);
                    const float rinv = __builtin_amdgcn_rsqf(ss * (1.0f / 64.0f) + NORM_EPS);
#pragma unroll
                    for (int bj = 0; bj < 2; ++bj) NT_STORE(u32x4, (base + r * 512 + hh * 64 + 32 * bj + 8 * fq), (pack8(acc[ai][bj][m][0] * rinv * g[bj][0], acc[ai][bj][m][1] * rinv * g[bj][1]))); }
        } else {
            const int gi = t - 12;
#pragma unroll
            for (int ai = ailo; ai < aihi; ++ai)
#pragma unroll
                for (int m = 0; m < 4; ++m) { const size_t r = row0 + ai * HALF + m * 16; f32x4 rr[2], sb[2];
#pragma unroll
                    for (int n = 0; n < 2; ++n)
#pragma unroll
                        for (int j = 0; j < 4; ++j) { float a = acc[ai][0][m][n][j], b = acc[ai][1][m][n][j];
                            a = fminf(fmaxf(a, -30.f), 30.f); b = fminf(fmaxf(b, -30.f), 30.f);
                            const float ea = __builtin_amdgcn_exp2f(-a * LOG2E), eb = __builtin_amdgcn_exp2f(-b * LOG2E);
                            const float ia = __builtin_amdgcn_rcpf(1.f + ea), ib = __builtin_amdgcn_rcpf(1.f + eb);
                            rr[n][j] = (1.f + eb) * ia; sb[n][j] = ib; }
                    ST_GATE(pack8(rr[0], rr[1]), (u32x4*)(R + r * D + gi * 128 + cb)); ST_GATE(pack8(sb[0], sb[1]), (u32x4*)(SB + r * D + gi * 128 + cb)); }
        }
    }
};
struct EpiMix {
    static constexpr bool HAS_MID = true; static constexpr int SW_ID = 14;
    struct Pre {}; __device__ __forceinline__ Pre pre(const Unit&, int, int) const { return Pre{}; }
    const bf16_t *R, *SB; bf16_t* O;
    __device__ __forceinline__ void mid(Acc& acc, const Unit& u, int wr, int wc, int fr, int fq) const {
        const size_t row0 = (size_t)u.pm * BM + wr * 64 + fr; const int col0 = u.pn * BM + wc * 32 + 8 * fq;
#pragma unroll
        for (int ai = 0; ai < 2; ++ai)
#pragma unroll
            for (int m = 0; m < 4; ++m) { const size_t r = row0 + ai * HALF + m * 16;
#pragma unroll
                for (int bj = 0; bj < 2; ++bj) { f32x4 a, b; unpack8(LD_EPI((const u32x4*)(R + r * D + col0 + bj * HALF)), a, b); acc[ai][bj][m][0] *= a; acc[ai][bj][m][1] *= b; } }
    }
    __device__ __forceinline__ void operator()(const Acc& acc, const Unit& u, int wr, int wc, int fr, int fq, const Pre&) const {
        const size_t row0 = (size_t)u.pm * BM + wr * 64 + fr; const int col0 = u.pn * BM + wc * 32 + 8 * fq;
        u32x4 sb[2][4][2];
#pragma unroll
        for (int ai = 0; ai < 2; ++ai)
#pragma unroll
            for (int m = 0; m < 4; ++m)
#pragma unroll
                for (int bj = 0; bj < 2; ++bj) sb[ai][m][bj] = LD_EPI((const u32x4*)(SB + (row0 + ai * HALF + m * 16) * D + col0 + bj * HALF));
#pragma unroll
        for (int ai = 0; ai < 2; ++ai)
#pragma unroll
            for (int m = 0; m < 4; ++m) { const size_t r = row0 + ai * HALF + m * 16;
#pragma unroll
                for (int bj = 0; bj < 2; ++bj) { f32x4 a, b; unpack8(sb[ai][m][bj], a, b);
                    NT_STORE(u32x4, (O + r * D + col0 + bj * HALF), (pack8(acc[ai][bj][m][0] * a, acc[ai][bj][m][1] * b))); } }
    }
};
struct EpiResid {
    static constexpr bool HAS_MID = false; static constexpr int SW_ID = 18;
    struct Pre {}; __device__ __forceinline__ Pre pre(const Unit&, int, int) const { return Pre{}; }
    const float* X; bf16_t* O;
    __device__ __forceinline__ void operator()(const Acc& acc, const Unit& u, int wr, int wc, int fr, int fq, const Pre&) const {
        const size_t row0 = (size_t)u.pm * BM + wr * 64 + fr; const int col0 = u.pn * BM + wc * 32 + 8 * fq;
#pragma unroll
        for (int ai = 0; ai < 2; ++ai) {
            f32x4 xv[4][2][2];
#pragma unroll
            for (int m = 0; m < 4; ++m)
#pragma unroll
                for (int bj = 0; bj < 2; ++bj) { const size_t o = (row0 + ai * HALF + m * 16) * D + col0 + bj * HALF; xv[m][bj][0] = LD_P4X((const f32x4*)(X + o)); xv[m][bj][1] = LD_P4X((const f32x4*)(X + o + 4)); }
#pragma unroll
            for (int m = 0; m < 4; ++m)
#pragma unroll
                for (int bj = 0; bj < 2; ++bj) { const size_t o = (row0 + ai * HALF + m * 16) * D + col0 + bj * HALF;
                    NT_STORE(u32x4, (O + o), (pack8(xv[m][bj][0] + acc[ai][bj][m][0], xv[m][bj][1] + acc[ai][bj][m][1]))); }
        }
    }
};
struct EpiSwiglu {
    static constexpr bool HAS_MID = false; static constexpr int SW_ID = 12;
    const float *bg, *bu; unsigned char* act;
    struct Pre { f32x4 g0, g1, u0, u1; };
    __device__ __forceinline__ Pre pre(const Unit& u, int wc, int fq) const { const int f0 = u.pn * 128 + wc * 32 + 8 * fq; Pre p;
        p.g0 = *(const f32x4*)(bg + u.e * FF + f0); p.g1 = *(const f32x4*)(bg + u.e * FF + f0 + 4); p.u0 = *(const f32x4*)(bu + u.e * FF + f0); p.u1 = *(const f32x4*)(bu + u.e * FF + f0 + 4); return p; }
    __device__ __forceinline__ void operator()(const Acc& acc, const Unit& u, int wr, int wc, int fr, int fq, const Pre& P) const {
        asm volatile("" : "+v"(fr), "+v"(fq));
        const int f0 = u.pn * 128 + wc * 32 + 8 * fq;
        const f32x4 g0 = P.g0, g1 = P.g1, u0 = P.u0, u1 = P.u1;
#pragma unroll
        for (int ai = 0; ai < 2; ++ai)
#pragma unroll
            for (int m = 0; m < 4; ++m) { const int rl = ai * HALF + wr * 64 + m * 16 + fr;
                if (rl < u.nvalid) {
                    const float rs = WINV;
                    f32x4 o[2];
#pragma unroll
                    for (int n = 0; n < 2; ++n)
#pragma unroll
                        for (int p = 0; p < 2; ++p) {
                            const f32x4 ga = acc[ai][0][m][n], ua = acc[ai][1][m][n], gbv = n ? g1 : g0, ubv = n ? u1 : u0;
                            const f32x2 gq = {ga[2 * p], ga[2 * p + 1]}, uq = {ua[2 * p], ua[2 * p + 1]}, gb2 = {gbv[2 * p], gbv[2 * p + 1]}, ub2 = {ubv[2 * p], ubv[2 * p + 1]};
                            f32x2 g = gq * rs + gb2; g.x = fminf(g.x, 7.0f); g.y = fminf(g.y, 7.0f);
                            f32x2 uu = uq * rs + ub2; uu.x = __builtin_amdgcn_fmed3f(uu.x, -7.0f, 7.0f); uu.y = __builtin_amdgcn_fmed3f(uu.y, -7.0f, 7.0f);
                            f32x2 x = g * (-1.702f * LOG2E); x.x = fminf(x.x, 60.0f); x.y = fminf(x.y, 60.0f);
                            f32x2 d; d.x = __builtin_amdgcn_exp2f(x.x); d.y = __builtin_amdgcn_exp2f(x.y); d = d + 1.0f;
                            const float r = __builtin_amdgcn_rcpf(d.x * d.y);
                            const f32x2 sg = {d.y * r, d.x * r};
                            const f32x2 ov = (g * sg) * (uu + 1.0f);
                            o[n][2 * p] = ov.x; o[n][2 * p + 1] = ov.y; }
                    NT_STORE(u32x2, (act + (size_t)(u.rowbase + rl) * FF + f0), (pack8_fp8(o[0], o[1]))); } }
    }
};
struct EpiDown {
    static constexpr bool HAS_MID = false; static constexpr int SW_ID = 13;
    const float* bd; unsigned char* Y;
    struct Pre { f32x4 b[2][2]; };
    __device__ __forceinline__ Pre pre(const Unit& u, int wc, int fq) const { const int col0 = u.pn * BM + wc * 32 + 8 * fq; Pre p;
#pragma unroll
        for (int bj = 0; bj < 2; ++bj) { p.b[bj][0] = *(const f32x4*)(bd + u.e * D + col0 + bj * HALF); p.b[bj][1] = *(const f32x4*)(bd + u.e * D + col0 + bj * HALF + 4); }
        return p; }
    __device__ __forceinline__ void operator()(const Acc& acc, const Unit& u, int wr, int wc, int fr, int fq, const Pre& P) const {
        asm volatile("" : "+v"(fr), "+v"(fq));
        const int col0 = u.pn * BM + wc * 32 + 8 * fq;
        unsigned char* yb = Y + (size_t)u.rowbase * D;
        f32x4 b[2][2];
#pragma unroll
        for (int bj = 0; bj < 2; ++bj) { b[bj][0] = P.b[bj][0]; b[bj][1] = P.b[bj][1]; }
#pragma unroll
        for (int ai = 0; ai < 2; ++ai)
#pragma unroll
            for (int m = 0; m < 4; ++m) { const int rl = ai * HALF + wr * 64 + m * 16 + fr;
                if (rl < u.nvalid) {
#pragma unroll
                    for (int bj = 0; bj < 2; ++bj) NT_STORE(u32x2, (yb + (size_t)rl * D + col0 + bj * HALF), (pack8_fp8(acc[ai][bj][m][0] * WINV + b[bj][0], acc[ai][bj][m][1] * WINV + b[bj][1]))); } }
    }
};
}

struct Args { const float* in[19]; float* out; unsigned char* ws; int ph_lo, ph_hi; };
struct Frame {
    LAS unsigned char* lds; volatile LAS unsigned* MISC; unsigned* ctl;
    int tid, lane, wave, G, bx;
    const float *x, *norm_mix, *w_in, *conv_w, *w_out_conv, *q_norm, *k_norm, *rpb, *w_out_attn, *w_o, *norm_ffn, *w_router, *b_router, *w_gate, *b_gate, *w_up, *b_up, *w_down, *b_down;
    float* out; unsigned char* ws;
};

__device__ __forceinline__ float wave_sum(float v) {
#pragma unroll
    for (int o = 1; o < 64; o <<= 1) v += __shfl_xor(v, o);
    return v;
}

__device__ __forceinline__ s16x4 tr_read(const LAS unsigned char* p) { return __builtin_bit_cast(s16x4, __builtin_amdgcn_ds_read_tr16_b64_v4i16((LAS s16x4*)p)); }
using pg8::pk_fp8x4;
__device__ __forceinline__ float bf2f(short h) { return __uint_as_float(((unsigned)(unsigned short)h) << 16); }
template <bool FP8>
__device__ __forceinline__ void p0_item(const float* W, int ldw, int k0, int c0a, int c0b  , unsigned char* dst  , int ldd  , const float* ks, float mul, LAS unsigned char* T, int lane) {
    constexpr int RS = 144;
    const int lq = lane >> 4, li = lane & 15, c0 = (li < 8 ? c0a : c0b) + 4 * (li & 7);
    f32x4 v[16];
#pragma unroll
    for (int i = 0; i < 16; ++i) v[i] = __builtin_nontemporal_load((const f32x4*)(W + (size_t)(k0 + 4 * i + lq) * ldw + c0));
#pragma unroll
    for (int i = 0; i < 16; ++i) { const int k = 4 * i + lq; const float sc = ks ? mul * ks[k0 + k] : mul; const f32x4 y = v[i] * sc;
        u32x2 w; w.x = cvt_pk_bf16(y[0], y[1]); w.y = cvt_pk_bf16(y[2], y[3]); *(LAS u32x2*)(T + k * RS + 8 * li) = w; }
    LDS_WAIT(); asm volatile("" ::: "memory");
    const LAS unsigned char* tb = T + (li >> 2) * RS + (li & 3) * 8;
#pragma unroll
    for (int nb = 0; nb < 4; ++nb) {
        if constexpr (FP8) {
            s16x4 t[4];
#pragma unroll
            for (int j = 0; j < 4; ++j) t[j] = tr_read(tb + (16 * lq + 4 * j) * RS + nb * 32);
            u32x4 o;
            o.x = pk_fp8x4(bf2f(t[0][0]), bf2f(t[0][1]), bf2f(t[0][2]), bf2f(t[0][3])); o.y = pk_fp8x4(bf2f(t[1][0]), bf2f(t[1][1]), bf2f(t[1][2]), bf2f(t[1][3]));
            o.z = pk_fp8x4(bf2f(t[2][0]), bf2f(t[2][1]), bf2f(t[2][2]), bf2f(t[2][3])); o.w = pk_fp8x4(bf2f(t[3][0]), bf2f(t[3][1]), bf2f(t[3][2]), bf2f(t[3][3]));
            ST_XW(o, (u32x4*)(dst + (size_t)(16 * nb + li) * ldd + 16 * lq));
        } else {
#pragma unroll
            for (int hf = 0; hf < 2; ++hf) { const int c = lq + 4 * hf;
                const s16x4 lo = tr_read(tb + (8 * c) * RS + nb * 32), hi = tr_read(tb + (8 * c + 4) * RS + nb * 32);
                const bf16x8 o = {lo[0], lo[1], lo[2], lo[3], hi[0], hi[1], hi[2], hi[3]};
                *(bf16x8*)(dst + (size_t)(16 * nb + li) * ldd + 16 * c) = o; }
        }
    }
    LDS_WAIT(); asm volatile("" ::: "memory");
}
__device__ __forceinline__ int inproj_srccol(int n0) {
    const int t = n0 >> 8, bj = (n0 >> 7) & 1, w = (n0 >> 5) & 3;
    if (t < 4) return (bj ? 1024 : 0) + 128 * t + 32 * w;
    if (t < 6) return 512 + 256 * (t - 4) + 128 * bj + 32 * w;
    if (t < 8) return 1536 + (4 * (t - 6) + w) * 64 + 32 * bj;
    if (t < 10) return 2048 + (4 * (t - 8) + w) * 64 + 32 * bj;
    if (t < 12) return 2560 + 256 * (t - 10) + 128 * bj + 32 * w;
    return (bj ? 4096 : 3072) + 128 * (t - 12) + 32 * w;
}
__device__ __forceinline__ void p0_prologue(Frame& F) {
    LAS unsigned char* T = F.lds + F.wave * 9216;
    const int gw = F.bx * NWAVES + F.wave, NGW = F.G * NWAVES, lane = F.lane;
    unsigned char* Win = F.ws + WS_WIN; unsigned char* Wca = F.ws + WS_WCA; unsigned char* Wo = F.ws + WS_WO;
    constexpr int I_IN = 16 * 80, I_CA = 2 * 8 * 16, I_O = 16 * 16;
    constexpr int NITEMS = I_IN + I_CA + I_O;
    SW_BEGIN(21)
    for (int it = gw; it < NITEMS; it += NGW) {
        int r = it;
        if (r < I_IN) { const int kb = r / 80, nb = r % 80; p0_item<false>(F.w_in, PROJW, 64 * kb, inproj_srccol(64 * nb), inproj_srccol(64 * nb + 32), Win + ((size_t)(64 * nb) * D + 64 * kb) * 2, D * 2, nullptr, 1.f, T, lane); continue; } r -= I_IN;
        if (r < I_CA) { const int s = r / 128, q = r % 128, kb = q / 16, nb = q % 16; p0_item<false>(s ? F.w_out_attn : F.w_out_conv, D, 64 * kb, 64 * nb, 64 * nb + 32, Wca + ((size_t)(64 * nb) * D + 512 * s + 64 * kb) * 2, D * 2, nullptr, 1.f, T, lane); continue; } r -= I_CA;
        { const int kb = r / 16, nb = r % 16; p0_item<false>(F.w_o, D, 64 * kb, 64 * nb, 64 * nb + 32, Wo + ((size_t)(64 * nb) * D + 64 * kb) * 2, D * 2, nullptr, 1.f, T, lane); }
    }
    SW_END(21);
    SW_BEGIN(22)
    { bf16_t* wh = (bf16_t*)(F.ws + WS_WRH); bf16_t* wl = (bf16_t*)(F.ws + WS_WRL);
      for (int i = F.bx * NTHREADS + F.tid; i < NE * D; i += F.G * NTHREADS) { const int e = i >> 10, k = i & 1023; const float v = F.w_router[k * NE + e] * F.norm_ffn[k];
          const unsigned h = cvt_pk_bf16(v, 0.f) & 0xffffu; const float lo = v - __uint_as_float(h << 16); wh[i] = (bf16_t)h; wl[i] = (bf16_t)(cvt_pk_bf16(lo, 0.f) & 0xffffu); } }
    SW_END(22);
    SW_BEGIN(23)
    bf16_t* Hb = (bf16_t*)F.out;
    for (int m0 = gw; m0 < M; m0 += 2 * NGW) {
        const int m1 = (m0 + NGW < M) ? m0 + NGW : m0;
        const f32x4* xr0 = (const f32x4*)(F.x + (size_t)m0 * D) + lane; const f32x4* xr1 = (const f32x4*)(F.x + (size_t)m1 * D) + lane;
        f32x4 v0[4], v1[4]; float s0 = 0.f, s1 = 0.f;
#pragma unroll
        for (int j = 0; j < 4; ++j) { v0[j] = LD_P0X(xr0 + 64 * j); v1[j] = LD_P0X(xr1 + 64 * j); }
#pragma unroll
        for (int j = 0; j < 4; ++j) { s0 += (v0[j][0] * v0[j][0] + v0[j][1] * v0[j][1]) + (v0[j][2] * v0[j][2] + v0[j][3] * v0[j][3]); s1 += (v1[j][0] * v1[j][0] + v1[j][1] * v1[j][1]) + (v1[j][2] * v1[j][2] + v1[j][3] * v1[j][3]); }
        const float r0 = 1.0f / sqrtf(wave_sum(s0) * (1.f / D) + NORM_EPS), r1 = 1.0f / sqrtf(wave_sum(s1) * (1.f / D) + NORM_EPS);
        unsigned long long* o0 = (unsigned long long*)(Hb + (size_t)m0 * D) + lane; unsigned long long* o1 = (unsigned long long*)(Hb + (size_t)m1 * D) + lane;
#pragma unroll
        for (int j = 0; j < 4; ++j) { const f32x4 g = *((const f32x4*)F.norm_mix + lane + 64 * j); const f32x4 y0 = v0[j] * r0 * g, y1 = v1[j] * r1 * g;
            o0[64 * j] = (unsigned long long)cvt_pk_bf16(y0[0], y0[1]) | ((unsigned long long)cvt_pk_bf16(y0[2], y0[3]) << 32);
            if (m1 != m0) o1[64 * j] = (unsigned long long)cvt_pk_bf16(y1[0], y1[1]) | ((unsigned long long)cvt_pk_bf16(y1[2], y1[3]) << 32); }
    }
    SW_END(23);
}

constexpr int XITEMS = NE * 16 * 32 + NE * 16 * 16, XITEMS_PER_WAVE = 12;
__device__ __forceinline__ void p0_expert_items(Frame& F, int k0, int k1) {
    LAS unsigned char* T = F.lds + F.wave * 9216;
    const int gw = F.bx * NWAVES + F.wave, NGW = F.G * NWAVES, lane = F.lane;
    unsigned char* Wd = F.ws + WS_WD; unsigned char* Wgu = F.ws + WS_WGU;
    constexpr int I_GU = NE * 16 * 32;
    for (int k = k0; k < k1; ++k) {
        for (int it = gw + k * NGW; it < XITEMS; it += NGW * XITEMS_PER_WAVE) {
            int r = it;
            if (r < I_GU) { const int e = r / 512, q = r % 512, kb = q / 32, nb = q % 32, n0 = 64 * nb, pn = n0 >> 8, bj = (n0 >> 7) & 1, c64 = n0 & 127;
                p0_item<true>((bj ? F.w_up : F.w_gate) + (size_t)e * D * FF, FF, 64 * kb, 128 * pn + c64, 128 * pn + c64 + 32, Wgu + ((size_t)e * 2048 + n0) * D + 64 * kb, D, F.norm_ffn, WSCALE, T, lane); }
            else { r -= I_GU; const int e = r / 256, q = r % 256, kb = q / 16, nb = q % 16;
                p0_item<true>(F.w_down + (size_t)e * FF * D, D, 64 * kb, 64 * nb, 64 * nb + 32, Wd + ((size_t)e * D + 64 * nb) * FF + 64 * kb, FF, nullptr, WSCALE, T, lane); }
        }
    }
}

__device__ __forceinline__ pg8::FillItem x_decode(const float* w_gate, const float* w_up, const float* w_down, const float* norm_ffn, unsigned char* ws, int it) {
    constexpr int I_GU = NE * 16 * 32; pg8::FillItem x; int r = it;
    if (r < I_GU) { const int e = r / 512, q = r % 512, kb = q / 32, nb = q % 32, n0 = 64 * nb, pn = n0 >> 8, bj = (n0 >> 7) & 1, c64 = n0 & 127;
        const unsigned long long sel = bj ? (unsigned long long)w_up : (unsigned long long)w_gate;
        x.W = (const float*)sel + (size_t)e * D * FF; x.ldw = FF; x.k0 = 64 * kb; x.c0a = 128 * pn + c64; x.dst = ws + WS_WGU + ((size_t)e * 2048 + n0) * D + 64 * kb; x.ldd = D; x.ks = norm_ffn; }
    else { r -= I_GU; const int e = r / 256, q = r % 256, kb = q / 16, nb = q % 16;
        x.W = w_down + (size_t)e * FF * D; x.ldw = D; x.k0 = 64 * kb; x.c0a = 64 * nb; x.dst = ws + WS_WD + ((size_t)e * D + 64 * nb) * FF + 64 * kb; x.ldd = FF; x.ks = nullptr; }
    return x;
}
#ifndef XF_EARLY
#define XF_EARLY 8
#endif
struct XFill {
    static constexpr int NV = 16; static constexpr bool SPLIT = true;
    const float *w_gate, *w_up, *w_down, *norm_ffn; unsigned char* ws; LAS unsigned char* lds; int gw, ngw, wave, lane, kbeg, kend;
    __device__ __forceinline__ bool begin(int ui, pg8::FillItem& x, f32x4 (&v)[16]) const {
        const int k = kbeg + ui; if (k >= kend) return false;
        int ln = lane; asm volatile("" : "+v"(ln));
        x = x_decode(w_gate, w_up, w_down, norm_ffn, ws, gw + k * ngw);
        const int lq = ln >> 4, li = ln & 15;
#pragma unroll
        for (int i = 0; i < XF_EARLY; ++i) v[i] = __builtin_nontemporal_load((const f32x4*)(x.W + (size_t)(x.k0 + 4 * i + lq) * x.ldw + x.c0a + 4 * li));
        return true; }
    __device__ __forceinline__ void finish(const pg8::FillItem& x, const f32x4 (&v)[16]) const {
        int ln = lane; asm volatile("" : "+v"(ln));
        constexpr int RS = 144; const int lq = ln >> 4, li = ln & 15;
        f32x4 vv[16];
#pragma unroll
        for (int i = 0; i < XF_EARLY; ++i) vv[i] = v[i];
#pragma unroll
        for (int i = XF_EARLY; i < 16; ++i) vv[i] = __builtin_nontemporal_load((const f32x4*)(x.W + (size_t)(x.k0 + 4 * i + lq) * x.ldw + x.c0a + 4 * li));
        LAS unsigned char* T = lds + 131072 + wave * 2304;
        const LAS unsigned char* tb = T + (li >> 2) * RS + (li & 3) * 8;
#pragma unroll
        for (int rr = 0; rr < 4; ++rr) {
#pragma unroll
            for (int i4 = 0; i4 < 4; ++i4) { const int i = 4 * rr + i4, k = 4 * i + lq; const float sc = x.ks ? WSCALE * x.ks[x.k0 + k] : WSCALE; const f32x4 y = vv[i] * sc;
                u32x2 w; w.x = cvt_pk_bf16(y[0], y[1]); w.y = cvt_pk_bf16(y[2], y[3]); *(LAS u32x2*)(T + (4 * i4 + lq) * RS + 8 * li) = w; }
            LDS_WAIT(); asm volatile("" ::: "memory");
            s16x4 t[4];
#pragma unroll
            for (int j = 0; j < 4; ++j) t[j] = tr_read(tb + (4 * j) * RS + lq * 32);
            u32x4 o;
            o.x = pk_fp8x4(bf2f(t[0][0]), bf2f(t[0][1]), bf2f(t[0][2]), bf2f(t[0][3])); o.y = pk_fp8x4(bf2f(t[1][0]), bf2f(t[1][1]), bf2f(t[1][2]), bf2f(t[1][3]));
            o.z = pk_fp8x4(bf2f(t[2][0]), bf2f(t[2][1]), bf2f(t[2][2]), bf2f(t[2][3])); o.w = pk_fp8x4(bf2f(t[3][0]), bf2f(t[3][1]), bf2f(t[3][2]), bf2f(t[3][3]));
            ST_XW(o, (u32x4*)(x.dst + (size_t)(16 * lq + li) * x.ldd + 16 * rr));
            LDS_WAIT(); asm volatile("" ::: "memory");
        }
    }
};

__device__ __forceinline__ void p2_conv(Frame& F) {
    const bf16_t* U = (const bf16_t*)(F.ws + WS_U); const bf16_t* Bg = (const bf16_t*)(F.ws + WS_BG); bf16_t* za = (bf16_t*)F.out + (size_t)M * D;
    const int c8 = (F.tid & 63) * 8;
    const f32x4 w00 = *(const f32x4*)(F.conv_w + c8), w01 = *(const f32x4*)(F.conv_w + c8 + 4), w10 = *(const f32x4*)(F.conv_w + CONVW + c8), w11 = *(const f32x4*)(F.conv_w + CONVW + c8 + 4),
                w20 = *(const f32x4*)(F.conv_w + 2 * CONVW + c8), w21 = *(const f32x4*)(F.conv_w + 2 * CONVW + c8 + 4);
    const int stride = F.G * NTHREADS;
    for (int it0 = F.bx * NTHREADS + F.tid; it0 < M * 64; it0 += 4 * stride) {
        u32x4 u0[4], um[4], up[4], bb[4];
#pragma unroll
        for (int j = 0; j < 4; ++j) { const int it = it0 + j * stride; const bool ok = it < M * 64; const int t = ok ? it >> 6 : 0, sq = t & (SEQ - 1);
            const u32x4 z4 = {0u, 0u, 0u, 0u};
            u0[j] = *(const u32x4*)(U + (size_t)t * CONVW + c8); um[j] = sq > 0 ? *(const u32x4*)(U + (size_t)(t - 1) * CONVW + c8) : z4; up[j] = sq < SEQ - 1 ? *(const u32x4*)(U + (size_t)(t + 1) * CONVW + c8) : z4;
            bb[j] = *(const u32x4*)(Bg + (size_t)t * CONVW + c8); }
#pragma unroll
        for (int j = 0; j < 4; ++j) { const int it = it0 + j * stride; if (it < M * 64) { const int t = it >> 6;
            f32x4 a0, a1, m0, m1, p0, p1, b0, b1; pg8::unpack8(u0[j], a0, a1); pg8::unpack8(um[j], m0, m1); pg8::unpack8(up[j], p0, p1); pg8::unpack8(bb[j], b0, b1);
            const f32x4 z0 = b0 * (w00 * m0 + w10 * a0 + w20 * p0), z1 = b1 * (w01 * m1 + w11 * a1 + w21 * p1);
            *(u32x4*)(za + (size_t)t * D + c8) = pg8::pack8(z0, z1); } }
    }
}
__device__ __forceinline__ void p2_attn(Frame& F, bf16_t* za) {
    const bf16_t* Q = (const bf16_t*)(F.ws + WS_Q); const bf16_t* Kp = (const bf16_t*)(F.ws + WS_K); const bf16_t* V = (const bf16_t*)(F.ws + WS_V);
    LAS unsigned char* Ks = F.lds; LAS unsigned char* Vs = F.lds + 65536; LAS float* rpbl = (LAS float*)(F.lds + LDS_X);
    for (int i = F.tid; i < NH * 15 * 31; i += NTHREADS) rpbl[i] = F.rpb[i] * LOG2E;
    const int lane = F.lane, g = lane >> 4, l15 = lane & 15;
    constexpr int NU = NB * NH * 32;
    u32x4 kv[8], vv[8]; bf16x8 qn[2];
#define ATT_LOAD(UN) do { const int h_ = (UN) & 7, cb_ = ((UN) >> 3) & 3, rb_ = ((UN) >> 5) & 7, b_ = (UN) >> 8; const int kr_ = clampi(8 * rb_ - 4, 0, 48), kc_ = clampi(16 * cb_ - 8, 0, 32); \
        _Pragma("unroll") for (int i = 0; i < 8; ++i) { const int cid = F.tid + NTHREADS * i, key = cid >> 3, c = cid & 7; const size_t tok = (size_t)b_ * SEQ + (kr_ + (key >> 5)) * 64 + kc_ + (key & 31); \
            kv[i] = *(const u32x4*)(Kp + tok * ATTW + h_ * HD + c * 8); vv[i] = *(const u32x4*)(V + tok * ATTW + h_ * HD + c * 8); } \
        { const size_t qt_ = (size_t)b_ * SEQ + (8 * rb_ + F.wave) * 64 + 16 * cb_ + l15; qn[0] = *(const bf16x8*)(Q + qt_ * ATTW + h_ * HD + 8 * g); qn[1] = *(const bf16x8*)(Q + qt_ * ATTW + h_ * HD + 32 + 8 * g); } } while (0)
    if (F.bx < NU) ATT_LOAD(F.bx);
    for (int un = F.bx; un < NU; un += F.G) {
        const int h = un & 7, cbk = (un >> 3) & 3, rb = (un >> 5) & 7, b = un >> 8;
        const int kr0 = clampi(8 * rb - 4, 0, 48), kc0 = clampi(16 * cbk - 8, 0, 32);
        __syncthreads();
#pragma unroll
        for (int i = 0; i < 8; ++i) { const int cid = F.tid + NTHREADS * i, key = cid >> 3, c = cid & 7;
            *(LAS u32x4*)(Ks + key * 128 + ((c ^ ((key >> 1) & 7)) << 4)) = kv[i]; *(LAS u32x4*)(Vs + key * 128 + ((c ^ (((key >> 1) & 3) << 1)) << 4)) = vv[i]; }
        __syncthreads();
        const int qr = 8 * rb + F.wave, rs = clampi(qr - 4, 0, 56), krs = rs - kr0, qc = 16 * cbk + l15, cs = clampi(qc - 8, 0, 48);
        const size_t qtok = (size_t)b * SEQ + qr * 64 + qc;
        const bf16x8 qf[2] = {qn[0], qn[1]};
        if (un + F.G < NU) ATT_LOAD(un + F.G);
        f32x4 sc[8][2];
#pragma unroll
        for (int jr = 0; jr < 8; ++jr)
#pragma unroll
            for (int f = 0; f < 2; ++f) { const int key = (krs + jr) * 32 + 16 * f + l15; f32x4 a = {0.f, 0.f, 0.f, 0.f};
#pragma unroll
                for (int ks = 0; ks < 2; ++ks) { const bf16x8 kf = *(const LAS bf16x8*)(Ks + key * 128 + (((4 * ks + g) ^ ((key >> 1) & 7)) << 4)); a = __builtin_amdgcn_mfma_f32_16x16x32_bf16(kf, qf[ks], a, 0, 0, 0); }
                sc[jr][f] = a; }
        float mx = -1e30f;
        const LAS float* ab = rpbl + h * 465 + (rs - qr + 7) * 31 + (kc0 + 4 * g - qc + 15);
        const int kd0 = kc0 + 4 * g - cs;
#pragma unroll
        for (int jh = 0; jh < 8; jh += 4) {
            float bs[4][2][4];
#pragma unroll
            for (int jj = 0; jj < 4; ++jj)
#pragma unroll
                for (int f = 0; f < 2; ++f)
#pragma unroll
                    for (int r = 0; r < 4; ++r) bs[jj][f][r] = ab[(jh + jj) * 31 + 16 * f + r];
            asm volatile("s_waitcnt lgkmcnt(0)" ::: "memory");
#pragma unroll
            for (int jj = 0; jj < 4; ++jj)
#pragma unroll
                for (int f = 0; f < 2; ++f)
#pragma unroll
                    for (int r = 0; r < 4; ++r) { const bool valid = (unsigned)(kd0 + 16 * f + r) < 16u;
                        const float sv = valid ? sc[jh + jj][f][r] + bs[jj][f][r] : -1e30f; sc[jh + jj][f][r] = sv; mx = fmaxf(mx, sv); }
        }
        mx = fmaxf(mx, __shfl_xor(mx, 16)); mx = fmaxf(mx, __shfl_xor(mx, 32));
        float sum = 0.f;
#pragma unroll
        for (int jr = 0; jr < 8; ++jr)
#pragma unroll
            for (int f = 0; f < 2; ++f)
#pragma unroll
                for (int r = 0; r < 4; ++r) { const float p = __builtin_amdgcn_exp2f(sc[jr][f][r] - mx); sc[jr][f][r] = p; sum += p; }
        sum += __shfl_xor(sum, 16); sum += __shfl_xor(sum, 32);
        f32x4 o[4];
#pragma unroll
        for (int db = 0; db < 4; ++db) o[db] = (f32x4){0.f, 0.f, 0.f, 0.f};
        const int q4 = l15 >> 2, p4 = lane & 3;
#pragma unroll
        for (int jr = 0; jr < 8; ++jr) {
            const u32x4 pw = pg8::pack8(sc[jr][0], sc[jr][1]); const bf16x8 pb = __builtin_bit_cast(bf16x8, pw);
            const int key1 = (krs + jr) * 32 + 4 * g + q4, key2 = key1 + 16;
#pragma unroll
            for (int db = 0; db < 4; ++db) { const int ch = 2 * db + (p4 >> 1);
                const s16x4 lo = tr_read(Vs + key1 * 128 + ((ch ^ (((key1 >> 1) & 3) << 1)) << 4) + 8 * (p4 & 1));
                const s16x4 hi = tr_read(Vs + key2 * 128 + ((ch ^ (((key2 >> 1) & 3) << 1)) << 4) + 8 * (p4 & 1));
                const bf16x8 vf = {lo[0], lo[1], lo[2], lo[3], hi[0], hi[1], hi[2], hi[3]};
                o[db] = __builtin_amdgcn_mfma_f32_16x16x32_bf16(vf, pb, o[db], 0, 0, 0); } }
        const float inv = 1.0f / sum;
#pragma unroll
        for (int db = 0; db < 4; ++db) { const f32x4 v = o[db] * inv; u32x2 w; w.x = cvt_pk_bf16(v[0], v[1]); w.y = cvt_pk_bf16(v[2], v[3]);
            *(u32x2*)(za + qtok * D + 512 + h * HD + 16 * db + 4 * g) = w; }
    }
    __syncthreads();
}

__device__ __forceinline__ void p5_router(Frame& F) {
    constexpr int RS = 2064;
    LAS unsigned char* Th = F.lds; LAS unsigned char* Tl = F.lds + 32 * RS;
    LAS float* lg = (LAS float*)(F.lds + LDS_X + F.wave * 2112);
    LAS unsigned* lcnt = (LAS unsigned*)(F.lds + LDS_CNT); LAS unsigned* lbase = lcnt + 32;
    const bf16_t* wh = (const bf16_t*)(F.ws + WS_WRH); const bf16_t* wl = (const bf16_t*)(F.ws + WS_WRL);
    for (int i = F.tid; i < 32 * 128; i += NTHREADS) { const int e = i >> 7, c = i & 127; *(LAS u32x4*)(Th + e * RS + c * 16) = *(const u32x4*)(wh + e * D + c * 8); *(LAS u32x4*)(Tl + e * RS + c * 16) = *(const u32x4*)(wl + e * D + c * 8); }
    const int lane = F.lane, g = lane >> 4, l15 = lane & 15;
    unsigned* rowtok = (unsigned*)(F.ws + WS_ROWTOK); unsigned* tokpos = (unsigned*)(F.ws + WS_TOKPOS); float* tokgate = (float*)(F.ws + WS_TOKGATE); float* rstd2 = (float*)(F.ws + WS_RSTD2);
    for (int ch = F.bx; ch < M / 128; ch += F.G) {
        if (F.tid < 32) lcnt[F.tid] = 0u;
        __syncthreads();
        const int t0 = ch * 128 + F.wave * 16;
        f32x4 a0 = {0.f, 0.f, 0.f, 0.f}, a1 = {0.f, 0.f, 0.f, 0.f}; float ssq = 0.f;
        const bf16_t* xp = (const bf16_t*)(F.ws + WS_X1) + (size_t)(t0 + l15) * D + 8 * g;
#pragma unroll 8
        for (int s = 0; s < 32; ++s) {
            const u32x4 xw = *(const u32x4*)(xp + 32 * s); f32x4 v0, v1; pg8::unpack8(xw, v0, v1);
            ssq += (v0[0] * v0[0] + v0[1] * v0[1]) + (v0[2] * v0[2] + v0[3] * v0[3]) + (v1[0] * v1[0] + v1[1] * v1[1]) + (v1[2] * v1[2] + v1[3] * v1[3]);
            const bf16x8 xh = __builtin_bit_cast(bf16x8, xw);
            const int ko = (32 * s + 8 * g) * 2;
            const bf16x8 bh0 = *(const LAS bf16x8*)(Th + l15 * RS + ko), bh1 = *(const LAS bf16x8*)(Th + (16 + l15) * RS + ko), bl0 = *(const LAS bf16x8*)(Tl + l15 * RS + ko), bl1 = *(const LAS bf16x8*)(Tl + (16 + l15) * RS + ko);
            a0 = __builtin_amdgcn_mfma_f32_16x16x32_bf16(xh, bh0, a0, 0, 0, 0); a0 = __builtin_amdgcn_mfma_f32_16x16x32_bf16(xh, bl0, a0, 0, 0, 0);
            a1 = __builtin_amdgcn_mfma_f32_16x16x32_bf16(xh, bh1, a1, 0, 0, 0); a1 = __builtin_amdgcn_mfma_f32_16x16x32_bf16(xh, bl1, a1, 0, 0, 0);
        }
        ssq += __shfl_xor(ssq, 16); ssq += __shfl_xor(ssq, 32);
        const float rstd = 1.0f / sqrtf(ssq * (1.f / D) + NORM_EPS);
        { unsigned char* x8 = F.ws + WS_XB + (size_t)(t0 + l15) * D + 8 * g;
#pragma unroll 1
          for (int s0 = 0; s0 < 32; s0 += 16) { u32x4 xw[16];
#pragma unroll
              for (int j = 0; j < 16; ++j) xw[j] = *(const u32x4*)(xp + 32 * (s0 + j));
#pragma unroll
              for (int j = 0; j < 16; ++j) { f32x4 v0, v1; pg8::unpack8(xw[j], v0, v1); *(u32x2*)(x8 + 32 * (s0 + j)) = pg8::pack8_fp8(v0 * rstd, v1 * rstd); } } }
        const float br0 = F.b_router[l15], br1 = F.b_router[16 + l15];
#pragma unroll
        for (int r = 0; r < 4; ++r) { const float rsr = __shfl(rstd, 4 * g + r); lg[(4 * g + r) * 33 + l15] = a0[r] * rsr + br0; lg[(4 * g + r) * 33 + 16 + l15] = a1[r] * rsr + br1; }
        LDS_WAIT(); asm volatile("" ::: "memory");
        int sel_e[4] = {0, 0, 0, 0}; float sel_g[4] = {0.f, 0.f, 0.f, 0.f}; unsigned lpos[4] = {0u, 0u, 0u, 0u};
        if (lane < 16) {
            float v[32];
#pragma unroll
            for (int e = 0; e < 32; ++e) v[e] = lg[lane * 33 + e];
            float tv[4];
#pragma unroll
            for (int k = 0; k < 4; ++k) { float best = -3.0e38f; int bi = 0;
#pragma unroll
                for (int e = 0; e < 32; ++e) { if (v[e] > best) { best = v[e]; bi = e; } }
#pragma unroll
                for (int e = 0; e < 32; ++e) { if (e == bi) v[e] = -3.0e38f; }
                tv[k] = best; sel_e[k] = bi; }
            float den = 0.f;
#pragma unroll
            for (int k = 0; k < 4; ++k) { sel_g[k] = __builtin_amdgcn_exp2f((tv[k] - tv[0]) * LOG2E); den += sel_g[k]; }
            const float idn = 1.0f / den;
#pragma unroll
            for (int k = 0; k < 4; ++k) { sel_g[k] *= idn; lpos[k] = __hip_atomic_fetch_add(lcnt + sel_e[k], 1u, __ATOMIC_RELAXED, __HIP_MEMORY_SCOPE_WORKGROUP); }
            rstd2[t0 + lane] = rstd;
        }
        __syncthreads();
        if (F.tid < 32) lbase[F.tid] = __hip_atomic_fetch_add(F.ctl + CW_CNT + 64 * F.tid, lcnt[F.tid], RLX_AGENT);
        __syncthreads();
        if (lane < 16) { const int tok = t0 + lane;
#pragma unroll
            for (int k = 0; k < 4; ++k) { const unsigned pos = lbase[sel_e[k]] + lpos[k]; rowtok[(size_t)sel_e[k] * CAP + pos] = (unsigned)tok; tokpos[tok * 4 + k] = ((unsigned)sel_e[k] << 20) | pos; tokgate[tok * 4 + k] = sel_g[k]; } }
        __syncthreads();
    }
}
__device__ __forceinline__ void moe_tables(Frame& F, LAS int* tab) {
    if (F.tid == 0) { int ts = 0, rs = 0;
        for (int e = 0; e < NE; ++e) { const int c = (int)__hip_atomic_load(F.ctl + CW_CNT + 64 * e, RLX_AGENT); tab[e] = ts; tab[40 + e] = c; tab[80 + e] = rs; ts += (c + 255) >> 8; rs += c; }
        tab[32] = ts; tab[112] = rs; }
    __syncthreads();
}
__device__ __forceinline__ void p8_combine(Frame& F, const LAS int* tab) {
    const u32x4* tokpos = (const u32x4*)(F.ws + WS_TOKPOS); const f32x4* tokgate = (const f32x4*)(F.ws + WS_TOKGATE);
    const unsigned char* Y = F.ws + WS_Y; const bf16_t* X1 = (const bf16_t*)(F.ws + WS_X1);
    const int gw = F.bx * NWAVES + F.wave, NGW = F.G * NWAVES, lane = F.lane;
    int t = gw; if (t >= M) return;
    u32x4 tp = tokpos[t]; f32x4 tg = tokgate[t];
    for (; t < M; t += NGW) {
        const int tn = (t + NGW < M) ? t + NGW : t;
        const u32x4 tpn = tokpos[tn]; const f32x4 tgn = tokgate[tn];
        u32x4 yw[4];
#pragma unroll
        for (int k = 0; k < 4; ++k) { const int e = tp[k] >> 20, pos = tp[k] & 0xfffff; const int row = tab[80 + e] + pos; yw[k] = LD_P8((const u32x4*)(Y + (size_t)row * D + 16 * lane)); }
        const u32x4 xa = LD_P8((const u32x4*)(X1 + (size_t)t * D + 16 * lane)), xb = LD_P8((const u32x4*)(X1 + (size_t)t * D + 16 * lane + 8));
        f32x4 o[4]; pg8::unpack8(xa, o[0], o[1]); pg8::unpack8(xb, o[2], o[3]);
#pragma unroll
        for (int k = 0; k < 4; ++k) { const float gk = tg[k];
#pragma unroll
            for (int q = 0; q < 4; ++q) { const f32x2 lo = __builtin_amdgcn_cvt_pk_f32_fp8((int)yw[k][q], false), hi = __builtin_amdgcn_cvt_pk_f32_fp8((int)yw[k][q], true);
                o[q][0] += gk * lo[0]; o[q][1] += gk * lo[1]; o[q][2] += gk * hi[0]; o[q][3] += gk * hi[1]; } }
        float* op = F.out + (size_t)t * D + 16 * lane;
#pragma unroll
        for (int q = 0; q < 4; ++q) ST_P8(o[q], (f32x4*)(op + 4 * q));
        tp = tpn; tg = tgn;
    }
}

#ifndef SLACK_US
#define SLACK_US 0
#endif
__device__ __forceinline__ void slack_delay(int nunits, int G, int c) {
    const int nmax = (nunits + G - 1) / G, mine = (nunits > c) ? (nunits - c + G - 1) / G : 0;
    if (mine < nmax && SLACK_US > 0) { const unsigned long long t0 = __builtin_amdgcn_s_memrealtime(); while (__builtin_amdgcn_s_memrealtime() - t0 < (unsigned long long)(SLACK_US * 100)) __builtin_amdgcn_s_sleep(16); }
}
constexpr int N_PHASES = 9;
#ifndef XPRE
#define XPRE 2
#endif
__global__ void __launch_bounds__(NTHREADS, 2) mk_fwd(Args args) {
    extern __shared__ __attribute__((aligned(16))) unsigned char lds_raw[];
    Frame F;
    F.lds = (LAS unsigned char*)lds_raw; F.MISC = (volatile LAS unsigned*)(F.lds + LDS_MISC);
    F.tid = threadIdx.x; F.lane = F.tid & 63; F.wave = __builtin_amdgcn_readfirstlane(F.tid >> 6); F.G = gridDim.x; F.bx = blockIdx.x;
    F.ws = args.ws; F.ctl = (unsigned*)(args.ws + WS_CTL); F.out = args.out;
    F.x = args.in[0]; F.norm_mix = args.in[1]; F.w_in = args.in[2]; F.conv_w = args.in[3]; F.w_out_conv = args.in[4]; F.q_norm = args.in[5]; F.k_norm = args.in[6]; F.rpb = args.in[7];
    F.w_out_attn = args.in[8]; F.w_o = args.in[9]; F.norm_ffn = args.in[10]; F.w_router = args.in[11]; F.b_router = args.in[12]; F.w_gate = args.in[13]; F.b_gate = args.in[14];
    F.w_up = args.in[15]; F.b_up = args.in[16]; F.w_down = args.in[17]; F.b_down = args.in[18];
    if (F.tid < 64) F.MISC[F.tid] = 0u;
    __syncthreads();
    XcdBarrier bar; bar.bar = F.ctl + CW_BAR; bar.x = 0; bar.st = nullptr;
#if !MK_MULTI
    bar = xcd_barrier_post(F.ctl + CW_BAR, F.MISC + 8);
#define GRID_BAR() do { SW_BEGIN(16) xcd_barrier(bar); SW_END(16); } while (0)
#else
#define GRID_BAR() do {} while (0)
#endif
    const int lo = args.ph_lo, hi = args.ph_hi;
#define IN(k) (lo <= (k) && (k) < hi)
#define SEAM(k) do { if (IN(k) && IN((k) + 1)) { SW_BEGIN(40) GRID_BAR(); SW_END_ID(40, 40 + (k)); } } while (0)
#ifndef PROBE_NOEPI
#define PROBE_NOEPI 0
#endif
#define NOEPI_ON(k) ((PROBE_NOEPI >> (k)) & 1)
#define REPS(k) (1 + ((PROBE_REP >> (k)) & 1))
#define REP_BEGIN(k) _Pragma("unroll") for (int rep_##k = 0; rep_##k < REPS(k); ++rep_##k) { if (rep_##k > 0) GRID_BAR();
#define REP_END }
    bf16_t* Hb = (bf16_t*)F.out; bf16_t* za = (bf16_t*)F.out + (size_t)M * D;
    LAS int* tab = (LAS int*)(F.lds + LDS_TAB);

    if (IN(0)) { SW_BEGIN(1) REP_BEGIN(0) p0_prologue(F); REP_END SEAM(0); SW_END(1); }
#if PROBE_SW == 19
    { xcd_barrier(bar); SW_BEGIN(19) xcd_barrier(bar); xcd_barrier(bar); xcd_barrier(bar); xcd_barrier(bar); SW_END(19); }
#endif
    if (IN(1)) {
        SW_BEGIN(2)
        pg8::DenseOrder S; S.init(Hb, F.ws + WS_WIN, M, PROJW, D * 2, F.G, F.bx);
        pg8::EpiInProj E{(bf16_t*)(F.ws + WS_U), (bf16_t*)(F.ws + WS_BG), (bf16_t*)(F.ws + WS_Q), (bf16_t*)(F.ws + WS_K), (bf16_t*)(F.ws + WS_V), (bf16_t*)(F.ws + WS_R), (bf16_t*)(F.ws + WS_SB), F.q_norm, F.k_norm};
        const bool std_grid = (F.G * NWAVES * XITEMS_PER_WAVE == XITEMS);
        const int npre = std_grid ? ((F.bx >> 3) & 3) * XPRE : XITEMS_PER_WAVE;
        { SW_BEGIN(10) p0_expert_items(F, 0, npre); __syncthreads(); SW_END(10); }
        const int nrounds = (S.nwg + F.G - 1) / F.G; const int kend = (npre + nrounds < XITEMS_PER_WAVE) ? npre + nrounds : XITEMS_PER_WAVE;
        XFill FL{F.w_gate, F.w_up, F.w_down, F.norm_ffn, F.ws, F.lds, F.bx * NWAVES + F.wave, F.G * NWAVES, F.wave, F.lane, npre, kend};
        pg8::gemm_phase<pg8::EpiInProj, pg8::DenseOrder, false, true, false, false, false, XFill>(F.lds, D * 2, S, E, FL);
        { SW_BEGIN(10) p0_expert_items(F, kend, XITEMS_PER_WAVE); SW_END(10); }
        SEAM(1);
        SW_END(2);
    }
    if (IN(2)) { SW_BEGIN(3) REP_BEGIN(2) REP_BEGIN(9) { SW_BEGIN(17) p2_conv(F); SW_END(17); } REP_END { const int nrep_ = ((PROBE_REP >> 10) & 1) ? (hi > 100 ? 1 : 2) : 1; _Pragma("unroll 1") for (int r_ = 0; r_ < nrep_; ++r_) { if (r_ > 0) GRID_BAR(); p2_attn(F, za); } } REP_END SEAM(2); SW_END(3); }
    if (IN(3)) {
        SW_BEGIN(4)
        pg8::DenseOrder S; S.init(za, F.ws + WS_WCA, M, D, D * 2, F.G, F.bx);
        pg8::EpiMix E{(const bf16_t*)(F.ws + WS_R), (const bf16_t*)(F.ws + WS_SB), (bf16_t*)(F.ws + WS_MIXED)};
#ifndef PROBE_P3
#define PROBE_P3 0
#endif
        if constexpr (PROBE_P3 == 1) { pg8::gemm_phase<pg8::EpiMix, pg8::DenseOrder, false, true, false, true, true>(F.lds, D * 2, S, E); GRID_BAR(); }
        if constexpr (PROBE_P3 == 2) { pg8::gemm_phase<pg8::EpiMix, pg8::DenseOrder, false, true, false, true, false>(F.lds, D * 2, S, E); GRID_BAR(); }
        REP_BEGIN(3) pg8::gemm_phase<pg8::EpiMix, pg8::DenseOrder, false, true, false>(F.lds, D * 2, S, E); REP_END
        SEAM(3);
        SW_END(4);
    }
    if (IN(4)) {
        SW_BEGIN(5)
        pg8::DenseOrder S; S.init(F.ws + WS_MIXED, F.ws + WS_WO, M, D, D * 2, F.G, F.bx);
        pg8::EpiResid E{F.x, (bf16_t*)(F.ws + WS_X1)};
        REP_BEGIN(4) pg8::gemm_phase<pg8::EpiResid, pg8::DenseOrder, false, true, false>(F.lds, D * 2, S, E); REP_END
        SEAM(4);
        SW_END(5);
    }
    if (IN(5)) {
        if constexpr ((PROBE_REP >> 5) & 1) { p5_router(F); GRID_BAR(); if (F.bx == 0 && F.tid < NE) __hip_atomic_store(F.ctl + CW_CNT + 64 * F.tid, 0u, RLX_AGENT); GRID_BAR(); }
        { SW_BEGIN(6) p5_router(F); SEAM(5); SW_END(6); } }
    if (IN(6)) {
        SW_BEGIN(7)
        moe_tables(F, tab);
        const int ntiles = tab[32];
        pg8::MoeOrder S; S.init(F.ws + WS_XB, F.ws + WS_WGU, (const unsigned*)(F.ws + WS_ROWTOK), tab, 0, ntiles, 2 * FF, D, F.G, F.bx, true);
        pg8::EpiSwiglu E{F.b_gate, F.b_up, F.ws + WS_ACT};
        slack_delay(ntiles * 8, F.G, F.bx);
        if constexpr (NOEPI_ON(6)) { pg8::gemm_phase<pg8::EpiSwiglu, pg8::MoeOrder, true, true, true, true>(F.lds, D, S, E); GRID_BAR(); }
        REP_BEGIN(6) pg8::gemm_phase<pg8::EpiSwiglu, pg8::MoeOrder, true, true, true>(F.lds, D, S, E); REP_END
        SEAM(6);
        SW_END(7);
    }
    if (IN(7) || IN(8)) {
        moe_tables(F, tab);
        const int ntiles = tab[32];
        if (IN(7)) {
            SW_BEGIN(8)
            pg8::EpiDown E{F.b_down, F.ws + WS_Y};
            pg8::MoeOrder S; S.init(F.ws + WS_ACT, F.ws + WS_WD, nullptr, tab, 0, ntiles, D, FF, F.G, F.bx, false);
            slack_delay(ntiles * 4, F.G, F.bx);
            if constexpr (NOEPI_ON(7)) { pg8::gemm_phase<pg8::EpiDown, pg8::MoeOrder, false, true, true, true>(F.lds, FF, S, E); GRID_BAR(); }
            REP_BEGIN(7) pg8::gemm_phase<pg8::EpiDown, pg8::MoeOrder, false, true, true>(F.lds, FF, S, E); REP_END
            SEAM(7);
            SW_END(8);
        }
        if (IN(8)) { SW_BEGIN(9) REP_BEGIN(8) p8_combine(F, tab); REP_END SW_END(9); }
    }
#if PROBE_SW
    if (F.bx == SW_BLOCK && F.tid == 0) { const unsigned long long tot = *(volatile LAS unsigned long long*)(size_t)(SW_LDS_OFF) * (unsigned long long)SW_MULT; const unsigned long long t0 = __builtin_amdgcn_s_memrealtime();
        while (__builtin_amdgcn_s_memrealtime() - t0 < tot) __builtin_amdgcn_s_sleep(8); }
#endif
}

extern "C" void kernel_launch(void* const* d_in, const int* in_sizes, int n_in, void* d_out, int out_size, void* d_ws, size_t ws_size, hipStream_t stream) {
    static int grid = 0;
    if (grid == 0) {
        if (n_in != 19 || out_size != M * D || ws_size < WS_END) { fprintf(stderr, "kernel_launch: unexpected shapes / workspace (%zu < %zu)\n", ws_size, (size_t)WS_END); grid = -1; return; }
        if (hipFuncSetAttribute((const void*)mk_fwd, hipFuncAttributeMaxDynamicSharedMemorySize, LDS_BYTES) != hipSuccess) { fprintf(stderr, "kernel_launch: hipFuncSetAttribute failed\n"); grid = -1; return; }
        int dev = 0, cus = 0, per_cu = 0;
        (void)hipGetDevice(&dev); (void)hipDeviceGetAttribute(&cus, hipDeviceAttributeMultiprocessorCount, dev);
        (void)hipOccupancyMaxActiveBlocksPerMultiprocessor(&per_cu, (const void*)mk_fwd, NTHREADS, LDS_BYTES);
        (void)hipGetLastError();
        grid = cus > 0 ? cus : 256;
    }
    if (grid < 0) return;
    (void)hipMemsetAsync((char*)d_ws + WS_CTL, 0, CTL_ZERO_BYTES, stream);
    Args a{};
    for (int i = 0; i < 19; ++i) a.in[i] = (const float*)d_in[i];
    a.out = (float*)d_out; a.ws = (unsigned char*)d_ws;
#if MK_MULTI
    for (int p = 0; p < N_PHASES; ++p) { a.ph_lo = p; a.ph_hi = p + 1; hipLaunchKernelGGL(mk_fwd, dim3(grid), dim3(NTHREADS), LDS_BYTES, stream, a); }
#else
    a.ph_lo = 0; a.ph_hi = N_PHASES;
    hipLaunchKernelGGL(mk_fwd, dim3(grid), dim3(NTHREADS), LDS_BYTES, stream, a);
#endif
}
```

```cpp
#include <hip/hip_runtime.h>
#include <cstdio>
#include <cstdint>

#ifndef MK_MULTI
#define MK_MULTI 0
#endif

#ifndef PROBE_REP
#define PROBE_REP 0
#endif
#ifndef NT_P0X
#define NT_P0X 1
#endif
#ifndef NT_P8
#define NT_P8 0
#endif
#ifndef NT_EPI
#define NT_EPI 0
#endif
#if NT_P0X
#define LD_P0X(p) __builtin_nontemporal_load(p)
#else
#define LD_P0X(p) (*(p))
#endif
#if NT_P8
#define LD_P8(p) __builtin_nontemporal_load(p)
#else
#define LD_P8(p) (*(p))
#endif
#ifndef NT_P8ST
#define NT_P8ST 0
#endif
#if NT_P8ST
#define ST_P8(v, p) __builtin_nontemporal_store(v, p)
#else
#define ST_P8(v, p) (*(p) = (v))
#endif
#ifndef NT_P4X
#define NT_P4X 0
#endif
#if NT_P4X
#define LD_P4X(p) __builtin_nontemporal_load(p)
#else
#define LD_P4X(p) (*(p))
#endif
#ifndef NT_XW
#define NT_XW 1
#endif
#ifndef NT_GATE
#define NT_GATE 1
#endif
#if NT_XW
#define ST_XW(v, p) __builtin_nontemporal_store(v, p)
#else
#define ST_XW(v, p) (*(p) = (v))
#endif
#if NT_GATE
#define ST_GATE(v, p) __builtin_nontemporal_store(v, p)
#else
#define ST_GATE(v, p) (*(p) = (v))
#endif
#if NT_EPI
#define LD_EPI(p) __builtin_nontemporal_load(p)
#else
#define LD_EPI(p) (*(p))
#endif
#define LAS __attribute__((address_space(3)))
#define GAS __attribute__((address_space(1)))
typedef unsigned short bf16_t;
typedef short bf16x8 __attribute__((ext_vector_type(8)));
typedef short s16x4 __attribute__((ext_vector_type(4)));
typedef float f32x4 __attribute__((ext_vector_type(4)));
typedef float f32x2 __attribute__((ext_vector_type(2)));
typedef unsigned u32x4 __attribute__((ext_vector_type(4)));
typedef unsigned u32x2 __attribute__((ext_vector_type(2)));

constexpr int D = 1024, NB = 8, SEQ = 4096, M = NB * SEQ;
constexpr int CONVW = 512, NH = 8, HD = 64, ATTW = 512, PROJW = 5120;
constexpr int NE = 32, TOPK = 4, FF = 1024, NASG = M * TOPK, CAP = M;
constexpr float NORM_EPS = 1e-6f, LOG2E = 1.4426950408889634f;
constexpr int NTHREADS = 512, NWAVES = 8;

constexpr size_t MiB = 1u << 20;
constexpr size_t WS_CTL = 0, CTL_ZERO_BYTES = 32 * 1024;
constexpr size_t WS_WRH = 1 * MiB, WS_WRL = 1 * MiB + 65536;
constexpr size_t WS_ROWTOK = 2 * MiB;
constexpr size_t WS_TOKPOS = 6 * MiB, WS_TOKGATE = 6 * MiB + 512 * 1024;
constexpr size_t WS_RSTD2 = 7 * MiB;
constexpr size_t WS_WIN = 8 * MiB, WS_WCA = 18 * MiB, WS_WO = 20 * MiB;
constexpr size_t WS_WD = 24 * MiB, WS_WGU = 56 * MiB;
constexpr size_t WS_XB = 120 * MiB;
constexpr size_t WS_ACT = 152 * MiB;
constexpr size_t WS_Y = 281 * MiB;
constexpr size_t WS_X1 = 409 * MiB;
constexpr size_t WS_END = WS_X1 + (size_t)M * D * 2;
static_assert(WS_ACT + (size_t)(NASG + 256) * FF <= WS_Y && WS_Y + (size_t)NASG * D <= WS_X1, "ws map");
constexpr size_t WS_U = 152 * MiB, WS_BG = 184 * MiB, WS_Q = 216 * MiB, WS_K = 248 * MiB, WS_V = 280 * MiB, WS_R = 312 * MiB, WS_SB = 376 * MiB;
constexpr size_t WS_MIXED = 152 * MiB;
constexpr float WSCALE = 64.0f, WINV = 1.0f / 64.0f;
constexpr int CW_TMO = 0, CW_CNT = 64  , CW_BAR = 4096;

constexpr int RING_BYTES = 131072;
constexpr int LDS_X = 132096;
constexpr int LDS_TAB = 148992;
constexpr int LDS_CNT = 149504;
constexpr int LDS_MISC = 149760;
constexpr int LDS_BYTES = 163840;
static_assert(LDS_MISC + 256 <= LDS_BYTES, "lds map");

#define RLX_AGENT __ATOMIC_RELAXED, __HIP_MEMORY_SCOPE_AGENT
#define LDS_WAIT() asm volatile("s_waitcnt lgkmcnt(0)" ::: "memory")
#define VM_WAIT() asm volatile("s_waitcnt vmcnt(0)" ::: "memory")
__device__ __forceinline__ unsigned cvt_pk_bf16(float lo, float hi) { unsigned r; asm volatile("v_cvt_pk_bf16_f32 %0, %1, %2" : "=v"(r) : "v"(lo), "v"(hi)); return r; }
__device__ __forceinline__ float bf_lo(unsigned w) { return __uint_as_float(w << 16); }
__device__ __forceinline__ float bf_hi(unsigned w) { return __uint_as_float(w & 0xffff0000u); }
__device__ __forceinline__ int clampi(int v, int lo, int hi) { return v < lo ? lo : (v > hi ? hi : v); }

#ifndef PROBE_SW
#define PROBE_SW 0
#endif
#ifndef SW_MULT
#define SW_MULT 8
#endif
#ifndef SW_BLOCK
#define SW_BLOCK 0
#endif
#define SW_LDS_OFF (149760 + 128)
#if PROBE_SW
#define SW_BEGIN(id) unsigned long long sw_t0_##id = 0ull; if (((PROBE_SW) == (id) || (id) == 30 || (id) == 40) && threadIdx.x == 0) sw_t0_##id = __builtin_amdgcn_s_memrealtime();
#define SW_END(id) do { if ((PROBE_SW) == (id) && threadIdx.x == 0) { volatile LAS unsigned long long* a_ = (volatile LAS unsigned long long*)(size_t)(SW_LDS_OFF); *a_ = *a_ + (__builtin_amdgcn_s_memrealtime() - sw_t0_##id); } } while (0)
#else
#define SW_BEGIN(id)
#define SW_END(id) do {} while (0)
#endif
#if PROBE_SW
#define SW_END_ID(var, id) do { if ((PROBE_SW) == (id) && threadIdx.x == 0) { volatile LAS unsigned long long* a_ = (volatile LAS unsigned long long*)(size_t)(SW_LDS_OFF); *a_ = *a_ + (__builtin_amdgcn_s_memrealtime() - sw_t0_##var); } } while (0)
#else
#define SW_END_ID(var, id) do {} while (0)
#endif
#define XB_TMO      128
#define XB_XCNT(j)  (256  + 64 * (j))
#define XB_XSUB(j)  (1280 + 64 * (j))
#define XB_XGEN(j)  (2304 + 64 * (j))
#define XB_TOP      3328
#define XB_TOPGEN   3392
#define XCD_BAR_WORDS 3456
#define XB_SPIN_CAP (1u << 18)
__device__ __forceinline__ unsigned xb_ld(unsigned* p)              { return __hip_atomic_load(p, __ATOMIC_RELAXED, __HIP_MEMORY_SCOPE_AGENT); }
__device__ __forceinline__ unsigned xb_add(unsigned* p, unsigned v) { return __hip_atomic_fetch_add(p, v, __ATOMIC_RELAXED, __HIP_MEMORY_SCOPE_AGENT); }
__device__ __forceinline__ unsigned xb_xcc_id() { return (unsigned)__builtin_amdgcn_s_getreg((3 << 11) | 20) & 0xFu; }
#define XB_SPIN(cond, bar) do { unsigned _sp = 0; while (cond) { __builtin_amdgcn_s_sleep(1); \
    if ((++_sp & 255u) == 0u) { if (xb_ld(&(bar)[XB_TMO])) break; if (_sp > XB_SPIN_CAP) { atomicAdd(&(bar)[XB_TMO], 1u); break; } } } } while (0)
struct XcdBarrier { unsigned* bar; unsigned x; volatile LAS unsigned* st; };
__device__ __forceinline__ XcdBarrier xcd_barrier_post(unsigned* bar, volatile LAS unsigned* st) {
    XcdBarrier b; b.bar = bar; b.x = xb_xcc_id(); b.st = st;
    if (threadIdx.x == 0) (void)xb_add(&bar[XB_XCNT(b.x)], 1u);
    return b;
}
__device__ __forceinline__ void xcd_barrier_complete(unsigned* bar, unsigned x, unsigned& nloc, unsigned& nx) {
    const unsigned G = gridDim.x * gridDim.y * gridDim.z;
    unsigned sum, cnt, mine, sp = 0u;
    for (;;) {
        sum = 0u; cnt = 0u; mine = 0u;
#pragma unroll
        for (unsigned j = 0; j < 16; ++j) { const unsigned c = xb_ld(&bar[XB_XCNT(j)]); sum += c; cnt += (c > 0u) ? 1u : 0u; mine = (j == x) ? c : mine; }
        if (sum == G) break;
        __builtin_amdgcn_s_sleep(1);
        if ((++sp & 255u) == 0u) { if (xb_ld(&bar[XB_TMO])) break; if (sp > XB_SPIN_CAP) { atomicAdd(&bar[XB_TMO], 1u); break; } }
    }
    nloc = mine > 0u ? mine : 1u; nx = cnt > 0u ? cnt : 1u;
}
__device__ __forceinline__ void xcd_barrier(const XcdBarrier& b) {
    asm volatile("s_waitcnt vmcnt(0)" ::: "memory");
    __syncthreads();
    if (threadIdx.x == 0) {
        unsigned* bar = b.bar;
        __builtin_amdgcn_s_waitcnt(0);
        unsigned nloc = b.st[0], nx = b.st[1];
        if (nloc == 0u) { xcd_barrier_complete(bar, b.x, nloc, nx); b.st[0] = nloc; b.st[1] = nx; }
        const unsigned old = xb_add(&bar[XB_XSUB(b.x)], 1u);
        const unsigned gen = old / nloc;
        if (old + 1u == (gen + 1u) * nloc) {
            __builtin_amdgcn_fence(__ATOMIC_RELEASE, "agent");
            asm volatile("s_waitcnt vmcnt(0)" ::: "memory");
            const unsigned og = xb_add(&bar[XB_TOP], 1u);
            const unsigned tg = og / nx;
            if (og + 1u == (tg + 1u) * nx) xb_add(&bar[XB_TOPGEN], 1u);
            else XB_SPIN(xb_ld(&bar[XB_TOPGEN]) == tg, bar);
            __builtin_amdgcn_fence(__ATOMIC_ACQUIRE, "agent");
            xb_add(&bar[XB_XGEN(b.x)], 1u);
            asm volatile("s_waitcnt vmcnt(0)" ::: "memory");
        } else {
            XB_SPIN(xb_ld(&bar[XB_XGEN(b.x)]) == gen, bar);
            __builtin_amdgcn_fence(__ATOMIC_ACQUIRE, "agent");
            asm volatile("s_waitcnt vmcnt(0)" ::: "memory");
        }
    }
    __syncthreads();
}

namespace pg8 {
constexpr int BM = 256, BK = 64, HALF = 128, HTB = HALF * BK * 2, NXCD = 8, WGM = 8;
__host__ __device__ __forceinline__ int lds_byte(int r, int c) { const int st = (r >> 4) * 2 + (c >> 5), rr = r & 15, cc = c & 31, ob = rr * 64 + cc * 2; return st * 1024 + (ob ^ (((ob >> 9) & 1) << 5)); }
__host__ __device__ __forceinline__ void stage_rc(int b, int& R, int& C) { const int st = b / 1024, sb = b % 1024, swz = sb ^ (((sb >> 9) & 1) << 5); R = (st >> 1) * 16 + swz / 64; C = (st & 1) * 32 + (swz % 64) / 2; }
__host__ __device__ __forceinline__ int perm32(int rho) { const int n = rho >> 4, i = rho & 15; return 8 * (i >> 2) + 4 * n + (i & 3); }

struct Unit { int pm, pn, e, nvalid, rowbase, lbase; };

struct DenseOrder {
    const char* A; const char* Bt; int nM, nN, nwg, G, c; size_t tstep;
    __device__ void init(const void* A_, const void* Bt_, int Mr, int N, int KB  , int G_, int c_) { A = (const char*)A_; Bt = (const char*)Bt_; nM = Mr / BM; nN = N / BM; nwg = nM * nN; G = G_; c = c_; tstep = (size_t)BM * KB; }
    __device__ __forceinline__ bool next(int i, Unit& u) const {
        const long L = (long)i * G + c; if (L >= nwg) return false;
        int wgid = (int)L; { const int q = nwg / NXCD, r = nwg % NXCD, xcd = wgid % NXCD, off = wgid / NXCD; wgid = (xcd < r ? xcd * (q + 1) : r * (q + 1) + (xcd - r) * q) + off; }
        const int nig = WGM * nN, gid = wgid / nig, fm = gid * WGM, gsz = (nM - fm) < WGM ? (nM - fm) : WGM;
        u.pm = fm + ((wgid % nig) % gsz); u.pn = (wgid % nig) / gsz; u.e = 0; u.nvalid = BM; u.rowbase = 0; u.lbase = 0; return true;
    }
    __device__ __forceinline__ unsigned a_off(const Unit& u) const { return (unsigned)u.pm * (unsigned)tstep; }
    __device__ __forceinline__ unsigned b_off(const Unit& u) const { return (unsigned)u.pn * (unsigned)tstep; }
    __device__ __forceinline__ unsigned row_tok(const Unit&, int) const { return 0u; }
};

struct MoeOrder {
    const char* A; const char* Bt; const unsigned* rowtok; const LAS int* tab; int tlo, nT, nN, nwg, G, c; size_t tstep, estride, rowbytes; bool gather;
    __device__ void init(const void* A_, const void* Bt_, const unsigned* rowtok_, const LAS int* tab_, int tlo_, int thi_, int N, int KB  , int G_, int c_, bool gather_) {
        A = (const char*)A_; Bt = (const char*)Bt_; rowtok = rowtok_; tab = tab_; tlo = tlo_; nT = thi_ - tlo_; if (nT < 0) nT = 0; nN = N / BM; nwg = nT * nN; G = G_; c = c_;
        tstep = (size_t)BM * KB; estride = (size_t)N * KB; rowbytes = (size_t)KB; gather = gather_; }
    __device__ __forceinline__ bool next(int i, Unit& u) const {
        const long L = (long)i * G + c; if (L >= nwg) return false;
        int wgid = (int)L; { const int q = nwg / NXCD, r = nwg % NXCD, xcd = wgid % NXCD, off = wgid / NXCD; wgid = (xcd < r ? xcd * (q + 1) : r * (q + 1) + (xcd - r) * q) + off; }
        const int nig = WGM * nN, gid = wgid / nig, fm = gid * WGM, gsz = (nT - fm) < WGM ? (nT - fm) : WGM;
        const int gt = tlo + fm + ((wgid % nig) % gsz), pn = (wgid % nig) / gsz;
        const int lane = threadIdx.x & 63;
        const int ts = (lane < 32) ? tab[lane] : 0x7fffffff;
        const unsigned long long mask = __ballot(ts <= gt);
        const int e = __builtin_popcountll(mask) - 1;
        const int j = gt - __builtin_amdgcn_readfirstlane(tab[e]);
        const int cnt = __builtin_amdgcn_readfirstlane(tab[40 + e]), es = __builtin_amdgcn_readfirstlane(tab[80 + e]);
        u.pm = gt; u.pn = pn; u.e = e; const int nv = cnt - 256 * j; u.nvalid = nv > 256 ? 256 : nv; u.rowbase = es + 256 * j; u.lbase = e * CAP + 256 * j; return true;
    }
    __device__ __forceinline__ unsigned a_off(const Unit& u) const { return gather ? 0u : (unsigned)u.rowbase * (unsigned)rowbytes; }
    __device__ __forceinline__ unsigned b_off(const Unit& u) const { return (unsigned)u.e * (unsigned)estride + (unsigned)u.pn * (unsigned)tstep; }
    __device__ __forceinline__ unsigned row_tok(const Unit& u, int r) const { const int rr = r < u.nvalid ? r : 0; return rowtok[u.lbase + rr]; }
};

typedef int v8i __attribute__((ext_vector_type(8))); typedef int v4i __attribute__((ext_vector_type(4)));
__device__ __forceinline__ v8i cat8(const bf16x8 a, const bf16x8 b) { return __builtin_shufflevector(__builtin_bit_cast(v4i, a), __builtin_bit_cast(v4i, b), 0, 1, 2, 3, 4, 5, 6, 7); }
template <class Epi, class Sched, bool GATHER, bool ALIGN_EPI, bool FP8, bool NOEPI = false, bool NOMID = false>
__device__ __forceinline__ void gemm_phase(LAS unsigned char* lds, const int KB, const Sched& S, const Epi& E) {
    const int tid = threadIdx.x, wid = __builtin_amdgcn_readfirstlane(tid >> 6), lane = tid & 63, wr = wid >> 2, wc = wid & 3, fr = lane & 15, fq = lane >> 4;
    const int nt = KB / 128;
    int Rst[2], Cst[2]; unsigned voffB[2];
#pragma unroll
    for (int i = 0; i < 2; ++i) { int R, C; stage_rc(tid * 16 + i * 8192, R, C); Rst[i] = R; Cst[i] = C; const int Rb = (R & ~31) + perm32(R & 31); voffB[i] = (unsigned)(Rb * KB + C * 2); }
    const unsigned kstep = 128u;
    const unsigned hstep = (unsigned)HALF * (unsigned)KB;
    const __amdgpu_buffer_rsrc_t rsA = __builtin_amdgcn_make_buffer_rsrc((void*)S.A, 0, 0x7ffffff0, 0x00020000), rsB = __builtin_amdgcn_make_buffer_rsrc((void*)S.Bt, 0, 0x7ffffff0, 0x00020000);
    const unsigned ldsw = (unsigned)wid * 1024u;
    const int aoff = lds_byte(wr * 64 + fr, fq * 8), boff = lds_byte(wc * 32 + fr, fq * 8);
#define PG8_SA(b, h) (((b) * 2 + (h)) * HTB)
#define PG8_SB(b, h) ((4 + (b) * 2 + (h)) * HTB)
#ifndef GLDS_BUF_ALL
#define GLDS_BUF_ALL 1
#endif
#define PG8_GLDS(rs, basep, voff, soff, ldsoff) do { if constexpr (FP8 || GLDS_BUF_ALL) __builtin_amdgcn_raw_ptr_buffer_load_lds(rs, (LAS unsigned*)(lds + (ldsoff)), 16, (int)(voff), (int)(soff), 0, 0); \
        else __builtin_amdgcn_global_load_lds((const unsigned*)((basep) + (size_t)(soff) + (voff)), (LAS unsigned*)(lds + (ldsoff)), 16, 0, 0); } while (0)
#define PG8_STAGE_B(bufoff, soff) do { PG8_GLDS(rsB, S.Bt, voffB[0], soff, (bufoff) + ldsw); PG8_GLDS(rsB, S.Bt, voffB[1], soff, (bufoff) + ldsw + 8192); } while (0)
#define PG8_STAGE_A(bufoff, soff, o0, o1) do { PG8_GLDS(rsA, S.A, o0, soff, (bufoff) + ldsw); PG8_GLDS(rsA, S.A, o1, soff, (bufoff) + ldsw + 8192); } while (0)
#define PG8_LDA(dst, b, h) do { _Pragma("unroll") for (int m = 0; m < 4; ++m) _Pragma("unroll") for (int k = 0; k < 2; ++k) dst[m][k] = *(const LAS bf16x8*)(lds + PG8_SA(b, h) + aoff + m * 2048 + k * 1024); } while (0)
#define PG8_LDB(dst, b, h) do { _Pragma("unroll") for (int n = 0; n < 2; ++n) _Pragma("unroll") for (int k = 0; k < 2; ++k) dst[n][k] = *(const LAS bf16x8*)(lds + PG8_SB(b, h) + boff + n * 2048 + k * 1024); } while (0)
#define PG8_MMA(ai, bj, At, Bt) do { __builtin_amdgcn_s_setprio(1); _Pragma("unroll") for (int m = 0; m < 4; ++m) _Pragma("unroll") for (int n = 0; n < 2; ++n) { \
        if constexpr (FP8) { const v8i b8_ = cat8(Bt[n][0], Bt[n][1]), a8_ = cat8(At[m][0], At[m][1]); asm volatile("v_mfma_f32_16x16x128_f8f6f4 %0, %1, %2, %0" : "+v"(acc[ai][bj][m][n]) : "v"(b8_), "v"(a8_)); } \
        else { _Pragma("unroll") for (int k = 0; k < 2; ++k) acc[ai][bj][m][n] = __builtin_amdgcn_mfma_f32_16x16x32_bf16(Bt[n][k], At[m][k], acc[ai][bj][m][n], 0, 0, 0); } } \
        __builtin_amdgcn_s_setprio(0); } while (0)
#define PG8_WAIT_V(n) asm volatile("s_waitcnt vmcnt(" #n ")" ::: "memory")
#define PG8_WAIT_L(n) asm volatile("s_waitcnt lgkmcnt(" #n ")" ::: "memory")
#define PG8_BAR __builtin_amdgcn_s_barrier()
#define PG8_SCHED __builtin_amdgcn_sched_barrier(0)
    Unit cur, nxt, nn; int ui = 0;
    if (!S.next(0, cur)) return;
    bool has_next = S.next(1, nxt);
    unsigned coff[2][2], noff[2][2];
#pragma unroll
    for (int h = 0; h < 2; ++h)
#pragma unroll
        for (int i = 0; i < 2; ++i) {
            if constexpr (GATHER) { coff[h][i] = S.row_tok(cur, h * HALF + Rst[i]) * (unsigned)KB + (unsigned)Cst[i] * 2u;
                                    noff[h][i] = has_next ? S.row_tok(nxt, h * HALF + Rst[i]) * (unsigned)KB + (unsigned)Cst[i] * 2u : coff[h][i]; }
            else { coff[h][i] = (unsigned)((h * HALF + Rst[i]) * KB + Cst[i] * 2); noff[h][i] = coff[h][i]; }
        }
    f32x4 acc[2][2][4][2];
#pragma unroll
    for (int a = 0; a < 2; ++a)
#pragma unroll
        for (int b = 0; b < 2; ++b)
#pragma unroll
            for (int m = 0; m < 4; ++m)
#pragma unroll
                for (int n = 0; n < 2; ++n) acc[a][b][m][n] = (f32x4){0.f, 0.f, 0.f, 0.f};
    bf16x8 At[4][2], B0[2][2], B1[2][2];
    unsigned cA = S.a_off(cur), cB = S.b_off(cur);
    typename Epi::Pre epre = E.pre(cur, wc, fq);
    PG8_STAGE_B(PG8_SB(0, 0), cB); PG8_STAGE_B(PG8_SB(0, 1), cB + hstep); PG8_STAGE_A(PG8_SA(0, 0), cA, coff[0][0], coff[0][1]); PG8_STAGE_A(PG8_SA(0, 1), cA, coff[1][0], coff[1][1]);
    if (wr == 1) PG8_BAR;
    PG8_WAIT_V(2); PG8_BAR;
    PG8_STAGE_B(PG8_SB(1, 0), cB + kstep); PG8_STAGE_A(PG8_SA(1, 0), cA + kstep, coff[0][0], coff[0][1]); PG8_STAGE_B(PG8_SB(1, 1), cB + hstep + kstep);
    PG8_WAIT_V(6); PG8_BAR;
    for (;;) {
        if constexpr (!GATHER) { if (ui > 0) has_next = S.next(ui + 1, nxt); }
        const unsigned nA = has_next ? S.a_off(nxt) : cA, nB = has_next ? S.b_off(nxt) : cB;
#pragma unroll 1
        for (int t = 0; t < nt; t += 2) {
            const bool last = (t == nt - 2);
            if constexpr (Epi::HAS_MID && !NOMID) { if (t == nt / 2) E.mid(acc, cur, wr, wc, fr, fq); }
            const unsigned a1 = cA + (unsigned)(t + 1) * kstep;
            const unsigned a2 = last ? nA : cA + (unsigned)(t + 2) * kstep, b2 = last ? nB : cB + (unsigned)(t + 2) * kstep;
            const unsigned a3 = a2 + kstep, b3 = b2 + kstep;
            unsigned x00, x01, x10, x11;
            if constexpr (GATHER) { x00 = last ? noff[0][0] : coff[0][0]; x01 = last ? noff[0][1] : coff[0][1]; x10 = last ? noff[1][0] : coff[1][0]; x11 = last ? noff[1][1] : coff[1][1]; }
            else { x00 = coff[0][0]; x01 = coff[0][1]; x10 = coff[1][0]; x11 = coff[1][1]; }
            PG8_LDB(B0, 0, 0); PG8_LDB(B1, 0, 1); PG8_SCHED; PG8_LDA(At, 0, 0); PG8_STAGE_A(PG8_SA(1, 1), a1, coff[1][0], coff[1][1]);
            PG8_WAIT_V(8); PG8_WAIT_L(0); PG8_BAR; PG8_MMA(0, 0, At, B0); PG8_MMA(0, 1, At, B1); PG8_BAR; PG8_SCHED;
            PG8_LDA(At, 0, 1); PG8_STAGE_B(PG8_SB(0, 0), b2); PG8_STAGE_B(PG8_SB(0, 1), b2 + hstep); PG8_STAGE_A(PG8_SA(0, 0), a2, x00, x01);
            PG8_WAIT_V(8); PG8_WAIT_L(0); PG8_BAR; PG8_MMA(1, 0, At, B0); PG8_MMA(1, 1, At, B1); PG8_BAR; PG8_SCHED;
            PG8_LDB(B0, 1, 0); PG8_LDB(B1, 1, 1); PG8_SCHED; PG8_LDA(At, 1, 0); PG8_STAGE_A(PG8_SA(0, 1), a2, x10, x11);
            PG8_WAIT_V(8); PG8_WAIT_L(0); PG8_BAR; PG8_MMA(0, 0, At, B0); PG8_MMA(0, 1, At, B1); PG8_BAR; PG8_SCHED;
            PG8_LDA(At, 1, 1); PG8_STAGE_B(PG8_SB(1, 0), b3); PG8_STAGE_B(PG8_SB(1, 1), b3 + hstep); PG8_STAGE_A(PG8_SA(1, 0), a3, x00, x01);
            PG8_WAIT_V(8); PG8_WAIT_L(0); PG8_BAR; PG8_MMA(1, 0, At, B0); PG8_MMA(1, 1, At, B1); PG8_BAR; PG8_SCHED;
        }
        if constexpr (FP8) asm volatile("s_nop 15\n\ts_nop 15" ::: "memory");
        if constexpr (ALIGN_EPI) { if (wr == 0) PG8_BAR; }
        bool has_nn = false; unsigned pend[2][2] = {{0u, 0u}, {0u, 0u}};
        if constexpr (GATHER) {
            has_nn = has_next && S.next(ui + 2, nn);
            if (has_nn) {
#pragma unroll
                for (int h = 0; h < 2; ++h)
#pragma unroll
                    for (int i = 0; i < 2; ++i) pend[h][i] = S.row_tok(nn, h * HALF + Rst[i]); }
        }
        if constexpr (NOEPI) {
#pragma unroll
            for (int a = 0; a < 2; ++a)
#pragma unroll
                for (int b = 0; b < 2; ++b)
#pragma unroll
                    for (int m = 0; m < 4; ++m) asm volatile("" :: "v"(acc[a][b][m][0]), "v"(acc[a][b][m][1]));
        } else { SW_BEGIN(30) E(acc, cur, wr, wc, fr, fq, epre); if ((PROBE_SW) == Epi::SW_ID) { asm volatile("s_waitcnt vmcnt(0)" ::: "memory"); } SW_END_ID(30, Epi::SW_ID); }
        if (!has_next) break;
#pragma unroll
        for (int a = 0; a < 2; ++a)
#pragma unroll
            for (int b = 0; b < 2; ++b)
#pragma unroll
                for (int m = 0; m < 4; ++m)
#pragma unroll
                    for (int n = 0; n < 2; ++n) acc[a][b][m][n] = (f32x4){0.f, 0.f, 0.f, 0.f};
        cur = nxt; cA = nA; cB = nB; ++ui;
        epre = E.pre(cur, wc, fq);
        if constexpr (GATHER) {
#pragma unroll
            for (int h = 0; h < 2; ++h)
#pragma unroll
                for (int i = 0; i < 2; ++i) { coff[h][i] = noff[h][i]; if (has_nn) noff[h][i] = pend[h][i] * (unsigned)KB + (unsigned)Cst[i] * 2u; }
            nxt = nn; has_next = has_nn;
        }
        if constexpr (ALIGN_EPI) { if (wr == 1) PG8_BAR; }
    }
    PG8_WAIT_V(0);
    if constexpr (!ALIGN_EPI) { if (wr == 0) PG8_BAR; }
    PG8_BAR;
#undef PG8_SA
#undef PG8_SB
#undef PG8_GLDS
#undef PG8_STAGE_A
#undef PG8_STAGE_B
#undef PG8_LDA
#undef PG8_LDB
#undef PG8_MMA
#undef PG8_WAIT_V
#undef PG8_WAIT_L
#undef PG8_BAR
#undef PG8_SCHED
}

typedef f32x4 Acc[2][2][4][2];
#ifndef EPI_NT
#define EPI_NT 0
#endif
#if EPI_NT
#define NT_STORE(T, p, v) __builtin_nontemporal_store((T)(v), (T*)(p))
#else
#define NT_STORE(T, p, v) (*(T*)(p) = (v))
#endif
__device__ __forceinline__ u32x4 pack8(const f32x4 a, const f32x4 b) { u32x4 w; w.x = cvt_pk_bf16(a[0], a[1]); w.y = cvt_pk_bf16(a[2], a[3]); w.z = cvt_pk_bf16(b[0], b[1]); w.w = cvt_pk_bf16(b[2], b[3]); return w; }
__device__ __forceinline__ unsigned pk_fp8x4(float a, float b, float c, float d) { int w = __builtin_amdgcn_cvt_pk_fp8_f32(a, b, 0, false); w = __builtin_amdgcn_cvt_pk_fp8_f32(c, d, w, true); return (unsigned)w; }
__device__ __forceinline__ u32x2 pack8_fp8(const f32x4 a, const f32x4 b) { u32x2 w; w.x = pk_fp8x4(a[0], a[1], a[2], a[3]); w.y = pk_fp8x4(b[0], b[1], b[2], b[3]); return w; }
__device__ __forceinline__ void unpack8(const u32x4 w, f32x4& a, f32x4& b) { a = (f32x4){bf_lo(w.x), bf_hi(w.x), bf_lo(w.y), bf_hi(w.y)}; b = (f32x4){bf_lo(w.z), bf_hi(w.z), bf_lo(w.w), bf_hi(w.w)}; }

struct EpiInProj {
    static constexpr bool HAS_MID = false; static constexpr int SW_ID = 11;
    struct Pre {}; __device__ __forceinline__ Pre pre(const Unit&, int, int) const { return Pre{}; }
    bf16_t *U, *Bg, *Q, *Kk, *V, *R, *SB; const float *qn, *kn;
    __device__ __forceinline__ void operator()(const Acc& acc, const Unit& u, int wr, int wc, int fr, int fq, const Pre&) const {
        const int t = u.pn; const size_t row0 = (size_t)u.pm * BM + wr * 64 + fr; const int cb = wc * 32 + 8 * fq;
        if (t < 4) {
#pragma unroll
            for (int ai = 0; ai < 2; ++ai)
#pragma unroll
                for (int m = 0; m < 4; ++m) { const size_t r = row0 + ai * HALF + m * 16;
                    NT_STORE(u32x4, (U + r * CONVW + t * 128 + cb), (pack8(acc[ai][0][m][0] * acc[ai][1][m][0], acc[ai][0][m][1] * acc[ai][1][m][1]))); }
        } else if (t < 6 || t == 10 || t == 11) {
            bf16_t* base = (t < 6) ? Bg + (t - 4) * 256 : V + (t - 10) * 256;
#pragma unroll
            for (int ai = 0; ai < 2; ++ai)
#pragma unroll
                for (int m = 0; m < 4; ++m) { const size_t r = row0 + ai * HALF + m * 16;
#pragma unroll
                    for (int bj = 0; bj < 2; ++bj) NT_STORE(u32x4, (base + r * 512 + bj * HALF + cb), (pack8(acc[ai][bj][m][0], acc[ai][bj][m][1]))); }
        } else if (t < 10) {
            const bool isq = t < 8; bf16_t* base = isq ? Q : Kk; const float* gn = isq ? qn : kn; const float sc = isq ? 0.125f * LOG2E : 1.0f;
            const int hh = 4 * (t & 1) + wc;
            f32x4 g[2][2];
#pragma unroll
            for (int bj = 0; bj < 2; ++bj) { g[bj][0] = *(const f32x4*)(gn + 32 * bj + 8 * fq) * sc; g[bj][1] = *(const f32x4*)(gn + 32 * bj + 8 * fq + 4) * sc; }
#pragma unroll
            for (int ai = 0; ai < 2; ++ai)
#pragma unroll
                for (int m = 0; m < 4; ++m) { const size_t r = row0 + ai * HALF + m * 16; float ss = 0.f;
#pragma unroll
                    for (int bj = 0; bj < 2; ++bj)
#pragma unroll
                        for (int n = 0; n < 2; ++n) { const f32x4 v = acc[ai][bj][m][n]; ss += (v[0] * v[0] + v[1] * v[1]) + (v[2] * v[2] + v[3] * v[3]); }
                    ss += __shfl_xor(ss, 16); ss += __shfl_xor(ss, 32);
                    const float rinv = __builtin_amdgcn_rsqf(ss * (1.0f / 64.0f) + NORM_EPS);
#pragma unroll
                    for (int bj = 0; bj < 2; ++bj) NT_STORE(u32x4, (base + r * 512 + hh * 64 + 32 * bj + 8 * fq), (pack8(acc[ai][bj][m][0] * rinv * g[bj][0], acc[ai][bj][m][1] * rinv * g[bj][1]))); }
        } else {
            const int gi = t - 12;
#pragma unroll
            for (int ai = 0; ai < 2; ++ai)
#pragma unroll
                for (int m = 0; m < 4; ++m) { const size_t r = row0 + ai * HALF + m * 16; f32x4 rr[2], sb[2];
#pragma unroll
                    for (int n = 0; n < 2; ++n)
#pragma unroll
                        for (int j = 0; j < 4; ++j) { float a = acc[ai][0][m][n][j], b = acc[ai][1][m][n][j];
                            a = fminf(fmaxf(a, -30.f), 30.f); b = fminf(fmaxf(b, -30.f), 30.f);
                            const float ea = __builtin_amdgcn_exp2f(-a * LOG2E), eb = __builtin_amdgcn_exp2f(-b * LOG2E);
                            const float ia = __builtin_amdgcn_rcpf(1.f + ea), ib = __builtin_amdgcn_rcpf(1.f + eb);
                            rr[n][j] = (1.f + eb) * ia; sb[n][j] = ib; }
                    ST_GATE(pack8(rr[0], rr[1]), (u32x4*)(R + r * D + gi * 128 + cb)); ST_GATE(pack8(sb[0], sb[1]), (u32x4*)(SB + r * D + gi * 128 + cb)); }
        }
    }
};
struct EpiMix {
    static constexpr bool HAS_MID = true; static constexpr int SW_ID = 14;
    struct Pre {}; __device__ __forceinline__ Pre pre(const Unit&, int, int) const { return Pre{}; }
    const bf16_t *R, *SB; bf16_t* O;
    __device__ __forceinline__ void mid(Acc& acc, const Unit& u, int wr, int wc, int fr, int fq) const {
        const size_t row0 = (size_t)u.pm * BM + wr * 64 + fr; const int col0 = u.pn * BM + wc * 32 + 8 * fq;
#pragma unroll
        for (int ai = 0; ai < 2; ++ai)
#pragma unroll
            for (int m = 0; m < 4; ++m) { const size_t r = row0 + ai * HALF + m * 16;
#pragma unroll
                for (int bj = 0; bj < 2; ++bj) { f32x4 a, b; unpack8(LD_EPI((const u32x4*)(R + r * D + col0 + bj * HALF)), a, b); acc[ai][bj][m][0] *= a; acc[ai][bj][m][1] *= b; } }
    }
    __device__ __forceinline__ void operator()(const Acc& acc, const Unit& u, int wr, int wc, int fr, int fq, const Pre&) const {
        const size_t row0 = (size_t)u.pm * BM + wr * 64 + fr; const int col0 = u.pn * BM + wc * 32 + 8 * fq;
        u32x4 sb[2][4][2];
#pragma unroll
        for (int ai = 0; ai < 2; ++ai)
#pragma unroll
            for (int m = 0; m < 4; ++m)
#pragma unroll
                for (int bj = 0; bj < 2; ++bj) sb[ai][m][bj] = LD_EPI((const u32x4*)(SB + (row0 + ai * HALF + m * 16) * D + col0 + bj * HALF));
#pragma unroll
        for (int ai = 0; ai < 2; ++ai)
#pragma unroll
            for (int m = 0; m < 4; ++m) { const size_t r = row0 + ai * HALF + m * 16;
#pragma unroll
                for (int bj = 0; bj < 2; ++bj) { f32x4 a, b; unpack8(sb[ai][m][bj], a, b);
                    NT_STORE(u32x4, (O + r * D + col0 + bj * HALF), (pack8(acc[ai][bj][m][0] * a, acc[ai][bj][m][1] * b))); } }
    }
};
struct EpiResid {
    static constexpr bool HAS_MID = false; static constexpr int SW_ID = 18;
    struct Pre {}; __device__ __forceinline__ Pre pre(const Unit&, int, int) const { return Pre{}; }
    const float* X; bf16_t* O;
    __device__ __forceinline__ void operator()(const Acc& acc, const Unit& u, int wr, int wc, int fr, int fq, const Pre&) const {
        const size_t row0 = (size_t)u.pm * BM + wr * 64 + fr; const int col0 = u.pn * BM + wc * 32 + 8 * fq;
#pragma unroll
        for (int ai = 0; ai < 2; ++ai) {
            f32x4 xv[4][2][2];
#pragma unroll
            for (int m = 0; m < 4; ++m)
#pragma unroll
                for (int bj = 0; bj < 2; ++bj) { const size_t o = (row0 + ai * HALF + m * 16) * D + col0 + bj * HALF; xv[m][bj][0] = LD_P4X((const f32x4*)(X + o)); xv[m][bj][1] = LD_P4X((const f32x4*)(X + o + 4)); }
#pragma unroll
            for (int m = 0; m < 4; ++m)
#pragma unroll
                for (int bj = 0; bj < 2; ++bj) { const size_t o = (row0 + ai * HALF + m * 16) * D + col0 + bj * HALF;
                    NT_STORE(u32x4, (O + o), (pack8(xv[m][bj][0] + acc[ai][bj][m][0], xv[m][bj][1] + acc[ai][bj][m][1]))); }
        }
    }
};
struct EpiSwiglu {
    static constexpr bool HAS_MID = false; static constexpr int SW_ID = 12;
    const float *bg, *bu; unsigned char* act;
    struct Pre { f32x4 g0, g1, u0, u1; };
    __device__ __forceinline__ Pre pre(const Unit& u, int wc, int fq) const { const int f0 = u.pn * 128 + wc * 32 + 8 * fq; Pre p;
        p.g0 = *(const f32x4*)(bg + u.e * FF + f0); p.g1 = *(const f32x4*)(bg + u.e * FF + f0 + 4); p.u0 = *(const f32x4*)(bu + u.e * FF + f0); p.u1 = *(const f32x4*)(bu + u.e * FF + f0 + 4); return p; }
    __device__ __forceinline__ void operator()(const Acc& acc, const Unit& u, int wr, int wc, int fr, int fq, const Pre& P) const {
        asm volatile("" : "+v"(fr), "+v"(fq));
        const int f0 = u.pn * 128 + wc * 32 + 8 * fq;
        const f32x4 g0 = P.g0, g1 = P.g1, u0 = P.u0, u1 = P.u1;
#pragma unroll
        for (int ai = 0; ai < 2; ++ai)
#pragma unroll
            for (int m = 0; m < 4; ++m) { const int rl = ai * HALF + wr * 64 + m * 16 + fr;
                if (rl < u.nvalid) {
                    const float rs = WINV;
                    f32x4 o[2];
#pragma unroll
                    for (int n = 0; n < 2; ++n)
#pragma unroll
                        for (int p = 0; p < 2; ++p) {
                            const f32x4 ga = acc[ai][0][m][n], ua = acc[ai][1][m][n], gbv = n ? g1 : g0, ubv = n ? u1 : u0;
                            const f32x2 gq = {ga[2 * p], ga[2 * p + 1]}, uq = {ua[2 * p], ua[2 * p + 1]}, gb2 = {gbv[2 * p], gbv[2 * p + 1]}, ub2 = {ubv[2 * p], ubv[2 * p + 1]};
                            f32x2 g = gq * rs + gb2; g.x = fminf(g.x, 7.0f); g.y = fminf(g.y, 7.0f);
                            f32x2 uu = uq * rs + ub2; uu.x = __builtin_amdgcn_fmed3f(uu.x, -7.0f, 7.0f); uu.y = __builtin_amdgcn_fmed3f(uu.y, -7.0f, 7.0f);
                            f32x2 x = g * (-1.702f * LOG2E); x.x = fminf(x.x, 60.0f); x.y = fminf(x.y, 60.0f);
                            f32x2 d; d.x = __builtin_amdgcn_exp2f(x.x); d.y = __builtin_amdgcn_exp2f(x.y); d = d + 1.0f;
                            const float r = __builtin_amdgcn_rcpf(d.x * d.y);
                            const f32x2 sg = {d.y * r, d.x * r};
                            const f32x2 ov = (g * sg) * (uu + 1.0f);
                            o[n][2 * p] = ov.x; o[n][2 * p + 1] = ov.y; }
                    NT_STORE(u32x2, (act + (size_t)(u.rowbase + rl) * FF + f0), (pack8_fp8(o[0], o[1]))); } }
    }
};
struct EpiDown {
    static constexpr bool HAS_MID = false; static constexpr int SW_ID = 13;
    const float* bd; unsigned char* Y;
    struct Pre { f32x4 b[2][2]; };
    __device__ __forceinline__ Pre pre(const Unit& u, int wc, int fq) const { const int col0 = u.pn * BM + wc * 32 + 8 * fq; Pre p;
#pragma unroll
        for (int bj = 0; bj < 2; ++bj) { p.b[bj][0] = *(const f32x4*)(bd + u.e * D + col0 + bj * HALF); p.b[bj][1] = *(const f32x4*)(bd + u.e * D + col0 + bj * HALF + 4); }
        return p; }
    __device__ __forceinline__ void operator()(const Acc& acc, const Unit& u, int wr, int wc, int fr, int fq, const Pre& P) const {
        asm volatile("" : "+v"(fr), "+v"(fq));
        const int col0 = u.pn * BM + wc * 32 + 8 * fq;
        unsigned char* yb = Y + (size_t)u.rowbase * D;
        f32x4 b[2][2];
#pragma unroll
        for (int bj = 0; bj < 2; ++bj) { b[bj][0] = P.b[bj][0]; b[bj][1] = P.b[bj][1]; }
#pragma unroll
        for (int ai = 0; ai < 2; ++ai)
#pragma unroll
            for (int m = 0; m < 4; ++m) { const int rl = ai * HALF + wr * 64 + m * 16 + fr;
                if (rl < u.nvalid) {
#pragma unroll
                    for (int bj = 0; bj < 2; ++bj) NT_STORE(u32x2, (yb + (size_t)rl * D + col0 + bj * HALF), (pack8_fp8(acc[ai][bj][m][0] * WINV + b[bj][0], acc[ai][bj][m][1] * WINV + b[bj][1]))); } }
    }
};
}

struct Args { const float* in[19]; float* out; unsigned char* ws; int ph_lo, ph_hi; };
struct Frame {
    LAS unsigned char* lds; volatile LAS unsigned* MISC; unsigned* ctl;
    int tid, lane, wave, G, bx;
    const float *x, *norm_mix, *w_in, *conv_w, *w_out_conv, *q_norm, *k_norm, *rpb, *w_out_attn, *w_o, *norm_ffn, *w_router, *b_router, *w_gate, *b_gate, *w_up, *b_up, *w_down, *b_down;
    float* out; unsigned char* ws;
};

__device__ __forceinline__ float wave_sum(float v) {
#pragma unroll
    for (int o = 1; o < 64; o <<= 1) v += __shfl_xor(v, o);
    return v;
}

__device__ __forceinline__ s16x4 tr_read(const LAS unsigned char* p) { return __builtin_bit_cast(s16x4, __builtin_amdgcn_ds_read_tr16_b64_v4i16((LAS s16x4*)p)); }
using pg8::pk_fp8x4;
__device__ __forceinline__ float bf2f(short h) { return __uint_as_float(((unsigned)(unsigned short)h) << 16); }
template <bool FP8>
__device__ __forceinline__ void p0_item(const float* W, int ldw, int k0, int c0a, int c0b  , unsigned char* dst  , int ldd  , const float* ks, float mul, LAS unsigned char* T, int lane) {
    constexpr int RS = 144;
    const int lq = lane >> 4, li = lane & 15, c0 = (li < 8 ? c0a : c0b) + 4 * (li & 7);
    f32x4 v[16];
#pragma unroll
    for (int i = 0; i < 16; ++i) v[i] = __builtin_nontemporal_load((const f32x4*)(W + (size_t)(k0 + 4 * i + lq) * ldw + c0));
#pragma unroll
    for (int i = 0; i < 16; ++i) { const int k = 4 * i + lq; const float sc = ks ? mul * ks[k0 + k] : mul; const f32x4 y = v[i] * sc;
        u32x2 w; w.x = cvt_pk_bf16(y[0], y[1]); w.y = cvt_pk_bf16(y[2], y[3]); *(LAS u32x2*)(T + k * RS + 8 * li) = w; }
    LDS_WAIT(); asm volatile("" ::: "memory");
    const LAS unsigned char* tb = T + (li >> 2) * RS + (li & 3) * 8;
#pragma unroll
    for (int nb = 0; nb < 4; ++nb) {
        if constexpr (FP8) {
            s16x4 t[4];
#pragma unroll
            for (int j = 0; j < 4; ++j) t[j] = tr_read(tb + (16 * lq + 4 * j) * RS + nb * 32);
            u32x4 o;
            o.x = pk_fp8x4(bf2f(t[0][0]), bf2f(t[0][1]), bf2f(t[0][2]), bf2f(t[0][3])); o.y = pk_fp8x4(bf2f(t[1][0]), bf2f(t[1][1]), bf2f(t[1][2]), bf2f(t[1][3]));
            o.z = pk_fp8x4(bf2f(t[2][0]), bf2f(t[2][1]), bf2f(t[2][2]), bf2f(t[2][3])); o.w = pk_fp8x4(bf2f(t[3][0]), bf2f(t[3][1]), bf2f(t[3][2]), bf2f(t[3][3]));
            ST_XW(o, (u32x4*)(dst + (size_t)(16 * nb + li) * ldd + 16 * lq));
        } else {
#pragma unroll
            for (int hf = 0; hf < 2; ++hf) { const int c = lq + 4 * hf;
                const s16x4 lo = tr_read(tb + (8 * c) * RS + nb * 32), hi = tr_read(tb + (8 * c + 4) * RS + nb * 32);
                const bf16x8 o = {lo[0], lo[1], lo[2], lo[3], hi[0], hi[1], hi[2], hi[3]};
                *(bf16x8*)(dst + (size_t)(16 * nb + li) * ldd + 16 * c) = o; }
        }
    }
    LDS_WAIT(); asm volatile("" ::: "memory");
}
__device__ __forceinline__ int inproj_srccol(int n0) {
    const int t = n0 >> 8, bj = (n0 >> 7) & 1, w = (n0 >> 5) & 3;
    if (t < 4) return (bj ? 1024 : 0) + 128 * t + 32 * w;
    if (t < 6) return 512 + 256 * (t - 4) + 128 * bj + 32 * w;
    if (t < 8) return 1536 + (4 * (t - 6) + w) * 64 + 32 * bj;
    if (t < 10) return 2048 + (4 * (t - 8) + w) * 64 + 32 * bj;
    if (t < 12) return 2560 + 256 * (t - 10) + 128 * bj + 32 * w;
    return (bj ? 4096 : 3072) + 128 * (t - 12) + 32 * w;
}
__device__ __forceinline__ void p0_prologue(Frame& F) {
    LAS unsigned char* T = F.lds + F.wave * 9216;
    const int gw = F.bx * NWAVES + F.wave, NGW = F.G * NWAVES, lane = F.lane;
    unsigned char* Win = F.ws + WS_WIN; unsigned char* Wca = F.ws + WS_WCA; unsigned char* Wo = F.ws + WS_WO;
    constexpr int I_IN = 16 * 80, I_CA = 2 * 8 * 16, I_O = 16 * 16;
    constexpr int NITEMS = I_IN + I_CA + I_O;
    SW_BEGIN(21)
    for (int it = gw; it < NITEMS; it += NGW) {
        int r = it;
        if (r < I_IN) { const int kb = r / 80, nb = r % 80; p0_item<false>(F.w_in, PROJW, 64 * kb, inproj_srccol(64 * nb), inproj_srccol(64 * nb + 32), Win + ((size_t)(64 * nb) * D + 64 * kb) * 2, D * 2, nullptr, 1.f, T, lane); continue; } r -= I_IN;
        if (r < I_CA) { const int s = r / 128, q = r % 128, kb = q / 16, nb = q % 16; p0_item<false>(s ? F.w_out_attn : F.w_out_conv, D, 64 * kb, 64 * nb, 64 * nb + 32, Wca + ((size_t)(64 * nb) * D + 512 * s + 64 * kb) * 2, D * 2, nullptr, 1.f, T, lane); continue; } r -= I_CA;
        { const int kb = r / 16, nb = r % 16; p0_item<false>(F.w_o, D, 64 * kb, 64 * nb, 64 * nb + 32, Wo + ((size_t)(64 * nb) * D + 64 * kb) * 2, D * 2, nullptr, 1.f, T, lane); }
    }
    SW_END(21);
    SW_BEGIN(22)
    { bf16_t* wh = (bf16_t*)(F.ws + WS_WRH); bf16_t* wl = (bf16_t*)(F.ws + WS_WRL);
      for (int i = F.bx * NTHREADS + F.tid; i < NE * D; i += F.G * NTHREADS) { const int e = i >> 10, k = i & 1023; const float v = F.w_router[k * NE + e] * F.norm_ffn[k];
          const unsigned h = cvt_pk_bf16(v, 0.f) & 0xffffu; const float lo = v - __uint_as_float(h << 16); wh[i] = (bf16_t)h; wl[i] = (bf16_t)(cvt_pk_bf16(lo, 0.f) & 0xffffu); } }
    SW_END(22);
    SW_BEGIN(23)
    bf16_t* Hb = (bf16_t*)F.out;
    for (int m0 = gw; m0 < M; m0 += 2 * NGW) {
        const int m1 = (m0 + NGW < M) ? m0 + NGW : m0;
        const f32x4* xr0 = (const f32x4*)(F.x + (size_t)m0 * D) + lane; const f32x4* xr1 = (const f32x4*)(F.x + (size_t)m1 * D) + lane;
        f32x4 v0[4], v1[4]; float s0 = 0.f, s1 = 0.f;
#pragma unroll
        for (int j = 0; j < 4; ++j) { v0[j] = LD_P0X(xr0 + 64 * j); v1[j] = LD_P0X(xr1 + 64 * j); }
#pragma unroll
        for (int j = 0; j < 4; ++j) { s0 += (v0[j][0] * v0[j][0] + v0[j][1] * v0[j][1]) + (v0[j][2] * v0[j][2] + v0[j][3] * v0[j][3]); s1 += (v1[j][0] * v1[j][0] + v1[j][1] * v1[j][1]) + (v1[j][2] * v1[j][2] + v1[j][3] * v1[j][3]); }
        const float r0 = 1.0f / sqrtf(wave_sum(s0) * (1.f / D) + NORM_EPS), r1 = 1.0f / sqrtf(wave_sum(s1) * (1.f / D) + NORM_EPS);
        unsigned long long* o0 = (unsigned long long*)(Hb + (size_t)m0 * D) + lane; unsigned long long* o1 = (unsigned long long*)(Hb + (size_t)m1 * D) + lane;
#pragma unroll
        for (int j = 0; j < 4; ++j) { const f32x4 g = *((const f32x4*)F.norm_mix + lane + 64 * j); const f32x4 y0 = v0[j] * r0 * g, y1 = v1[j] * r1 * g;
            o0[64 * j] = (unsigned long long)cvt_pk_bf16(y0[0], y0[1]) | ((unsigned long long)cvt_pk_bf16(y0[2], y0[3]) << 32);
            if (m1 != m0) o1[64 * j] = (unsigned long long)cvt_pk_bf16(y1[0], y1[1]) | ((unsigned long long)cvt_pk_bf16(y1[2], y1[3]) << 32); }
    }
    SW_END(23);
}

constexpr int XITEMS = NE * 16 * 32 + NE * 16 * 16, XITEMS_PER_WAVE = 12;
__device__ __forceinline__ void p0_expert_items(Frame& F, int k0, int k1) {
    LAS unsigned char* T = F.lds + F.wave * 9216;
    const int gw = F.bx * NWAVES + F.wave, NGW = F.G * NWAVES, lane = F.lane;
    unsigned char* Wd = F.ws + WS_WD; unsigned char* Wgu = F.ws + WS_WGU;
    constexpr int I_GU = NE * 16 * 32;
    for (int k = k0; k < k1; ++k) {
        for (int it = gw + k * NGW; it < XITEMS; it += NGW * XITEMS_PER_WAVE) {
            int r = it;
            if (r < I_GU) { const int e = r / 512, q = r % 512, kb = q / 32, nb = q % 32, n0 = 64 * nb, pn = n0 >> 8, bj = (n0 >> 7) & 1, c64 = n0 & 127;
                p0_item<true>((bj ? F.w_up : F.w_gate) + (size_t)e * D * FF, FF, 64 * kb, 128 * pn + c64, 128 * pn + c64 + 32, Wgu + ((size_t)e * 2048 + n0) * D + 64 * kb, D, F.norm_ffn, WSCALE, T, lane); }
            else { r -= I_GU; const int e = r / 256, q = r % 256, kb = q / 16, nb = q % 16;
                p0_item<true>(F.w_down + (size_t)e * FF * D, D, 64 * kb, 64 * nb, 64 * nb + 32, Wd + ((size_t)e * D + 64 * nb) * FF + 64 * kb, FF, nullptr, WSCALE, T, lane); }
        }
    }
}

__device__ __forceinline__ void p2_conv(Frame& F) {
    const bf16_t* U = (const bf16_t*)(F.ws + WS_U); const bf16_t* Bg = (const bf16_t*)(F.ws + WS_BG); bf16_t* za = (bf16_t*)F.out + (size_t)M * D;
    const int c8 = (F.tid & 63) * 8;
    const f32x4 w00 = *(const f32x4*)(F.conv_w + c8), w01 = *(const f32x4*)(F.conv_w + c8 + 4), w10 = *(const f32x4*)(F.conv_w + CONVW + c8), w11 = *(const f32x4*)(F.conv_w + CONVW + c8 + 4),
                w20 = *(const f32x4*)(F.conv_w + 2 * CONVW + c8), w21 = *(const f32x4*)(F.conv_w + 2 * CONVW + c8 + 4);
    const int stride = F.G * NTHREADS;
    for (int it0 = F.bx * NTHREADS + F.tid; it0 < M * 64; it0 += 4 * stride) {
        u32x4 u0[4], um[4], up[4], bb[4];
#pragma unroll
        for (int j = 0; j < 4; ++j) { const int it = it0 + j * stride; const bool ok = it < M * 64; const int t = ok ? it >> 6 : 0, sq = t & (SEQ - 1);
            const u32x4 z4 = {0u, 0u, 0u, 0u};
            u0[j] = *(const u32x4*)(U + (size_t)t * CONVW + c8); um[j] = sq > 0 ? *(const u32x4*)(U + (size_t)(t - 1) * CONVW + c8) : z4; up[j] = sq < SEQ - 1 ? *(const u32x4*)(U + (size_t)(t + 1) * CONVW + c8) : z4;
            bb[j] = *(const u32x4*)(Bg + (size_t)t * CONVW + c8); }
#pragma unroll
        for (int j = 0; j < 4; ++j) { const int it = it0 + j * stride; if (it < M * 64) { const int t = it >> 6;
            f32x4 a0, a1, m0, m1, p0, p1, b0, b1; pg8::unpack8(u0[j], a0, a1); pg8::unpack8(um[j], m0, m1); pg8::unpack8(up[j], p0, p1); pg8::unpack8(bb[j], b0, b1);
            const f32x4 z0 = b0 * (w00 * m0 + w10 * a0 + w20 * p0), z1 = b1 * (w01 * m1 + w11 * a1 + w21 * p1);
            *(u32x4*)(za + (size_t)t * D + c8) = pg8::pack8(z0, z1); } }
    }
}
__device__ __forceinline__ void p2_attn(Frame& F, bf16_t* za) {
    const bf16_t* Q = (const bf16_t*)(F.ws + WS_Q); const bf16_t* Kp = (const bf16_t*)(F.ws + WS_K); const bf16_t* V = (const bf16_t*)(F.ws + WS_V);
    LAS unsigned char* Ks = F.lds; LAS unsigned char* Vs = F.lds + 65536; LAS float* rpbl = (LAS float*)(F.lds + LDS_X);
    for (int i = F.tid; i < NH * 15 * 31; i += NTHREADS) rpbl[i] = F.rpb[i] * LOG2E;
    const int lane = F.lane, g = lane >> 4, l15 = lane & 15;
    constexpr int NU = NB * NH * 32;
    u32x4 kv[8], vv[8]; bf16x8 qn[2];
#define ATT_LOAD(UN) do { const int h_ = (UN) & 7, cb_ = ((UN) >> 3) & 3, rb_ = ((UN) >> 5) & 7, b_ = (UN) >> 8; const int kr_ = clampi(8 * rb_ - 4, 0, 48), kc_ = clampi(16 * cb_ - 8, 0, 32); \
        _Pragma("unroll") for (int i = 0; i < 8; ++i) { const int cid = F.tid + NTHREADS * i, key = cid >> 3, c = cid & 7; const size_t tok = (size_t)b_ * SEQ + (kr_ + (key >> 5)) * 64 + kc_ + (key & 31); \
            kv[i] = *(const u32x4*)(Kp + tok * ATTW + h_ * HD + c * 8); vv[i] = *(const u32x4*)(V + tok * ATTW + h_ * HD + c * 8); } \
        { const size_t qt_ = (size_t)b_ * SEQ + (8 * rb_ + F.wave) * 64 + 16 * cb_ + l15; qn[0] = *(const bf16x8*)(Q + qt_ * ATTW + h_ * HD + 8 * g); qn[1] = *(const bf16x8*)(Q + qt_ * ATTW + h_ * HD + 32 + 8 * g); } } while (0)
    if (F.bx < NU) ATT_LOAD(F.bx);
    for (int un = F.bx; un < NU; un += F.G) {
        const int h = un & 7, cbk = (un >> 3) & 3, rb = (un >> 5) & 7, b = un >> 8;
        const int kr0 = clampi(8 * rb - 4, 0, 48), kc0 = clampi(16 * cbk - 8, 0, 32);
        __syncthreads();
#pragma unroll
        for (int i = 0; i < 8; ++i) { const int cid = F.tid + NTHREADS * i, key = cid >> 3, c = cid & 7;
            *(LAS u32x4*)(Ks + key * 128 + ((c ^ ((key >> 1) & 7)) << 4)) = kv[i]; *(LAS u32x4*)(Vs + key * 128 + ((c ^ (((key >> 1) & 3) << 1)) << 4)) = vv[i]; }
        __syncthreads();
        const int qr = 8 * rb + F.wave, rs = clampi(qr - 4, 0, 56), krs = rs - kr0, qc = 16 * cbk + l15, cs = clampi(qc - 8, 0, 48);
        const size_t qtok = (size_t)b * SEQ + qr * 64 + qc;
        const bf16x8 qf[2] = {qn[0], qn[1]};
        if (un + F.G < NU) ATT_LOAD(un + F.G);
        f32x4 sc[8][2];
#pragma unroll
        for (int jr = 0; jr < 8; ++jr)
#pragma unroll
            for (int f = 0; f < 2; ++f) { const int key = (krs + jr) * 32 + 16 * f + l15; f32x4 a = {0.f, 0.f, 0.f, 0.f};
#pragma unroll
                for (int ks = 0; ks < 2; ++ks) { const bf16x8 kf = *(const LAS bf16x8*)(Ks + key * 128 + (((4 * ks + g) ^ ((key >> 1) & 7)) << 4)); a = __builtin_amdgcn_mfma_f32_16x16x32_bf16(kf, qf[ks], a, 0, 0, 0); }
                sc[jr][f] = a; }
        float mx = -1e30f;
        const LAS float* ab = rpbl + h * 465 + (rs - qr + 7) * 31 + (kc0 + 4 * g - qc + 15);
        const int kd0 = kc0 + 4 * g - cs;
#pragma unroll
        for (int jh = 0; jh < 8; jh += 4) {
            float bs[4][2][4];
#pragma unroll
            for (int jj = 0; jj < 4; ++jj)
#pragma unroll
                for (int f = 0; f < 2; ++f)
#pragma unroll
                    for (int r = 0; r < 4; ++r) bs[jj][f][r] = ab[(jh + jj) * 31 + 16 * f + r];
            asm volatile("s_waitcnt lgkmcnt(0)" ::: "memory");
#pragma unroll
            for (int jj = 0; jj < 4; ++jj)
#pragma unroll
                for (int f = 0; f < 2; ++f)
#pragma unroll
                    for (int r = 0; r < 4; ++r) { const bool valid = (unsigned)(kd0 + 16 * f + r) < 16u;
                        const float sv = valid ? sc[jh + jj][f][r] + bs[jj][f][r] : -1e30f; sc[jh + jj][f][r] = sv; mx = fmaxf(mx, sv); }
        }
        mx = fmaxf(mx, __shfl_xor(mx, 16)); mx = fmaxf(mx, __shfl_xor(mx, 32));
        float sum = 0.f;
#pragma unroll
        for (int jr = 0; jr < 8; ++jr)
#pragma unroll
            for (int f = 0; f < 2; ++f)
#pragma unroll
                for (int r = 0; r < 4; ++r) { const float p = __builtin_amdgcn_exp2f(sc[jr][f][r] - mx); sc[jr][f][r] = p; sum += p; }
        sum += __shfl_xor(sum, 16); sum += __shfl_xor(sum, 32);
        f32x4 o[4];
#pragma unroll
        for (int db = 0; db < 4; ++db) o[db] = (f32x4){0.f, 0.f, 0.f, 0.f};
        const int q4 = l15 >> 2, p4 = lane & 3;
#pragma unroll
        for (int jr = 0; jr < 8; ++jr) {
            const u32x4 pw = pg8::pack8(sc[jr][0], sc[jr][1]); const bf16x8 pb = __builtin_bit_cast(bf16x8, pw);
            const int key1 = (krs + jr) * 32 + 4 * g + q4, key2 = key1 + 16;
#pragma unroll
            for (int db = 0; db < 4; ++db) { const int ch = 2 * db + (p4 >> 1);
                const s16x4 lo = tr_read(Vs + key1 * 128 + ((ch ^ (((key1 >> 1) & 3) << 1)) << 4) + 8 * (p4 & 1));
                const s16x4 hi = tr_read(Vs + key2 * 128 + ((ch ^ (((key2 >> 1) & 3) << 1)) << 4) + 8 * (p4 & 1));
                const bf16x8 vf = {lo[0], lo[1], lo[2], lo[3], hi[0], hi[1], hi[2], hi[3]};
                o[db] = __builtin_amdgcn_mfma_f32_16x16x32_bf16(vf, pb, o[db], 0, 0, 0); } }
        const float inv = 1.0f / sum;
#pragma unroll
        for (int db = 0; db < 4; ++db) { const f32x4 v = o[db] * inv; u32x2 w; w.x = cvt_pk_bf16(v[0], v[1]); w.y = cvt_pk_bf16(v[2], v[3]);
            *(u32x2*)(za + qtok * D + 512 + h * HD + 16 * db + 4 * g) = w; }
    }
    __syncthreads();
}

__device__ __forceinline__ void p5_router(Frame& F) {
    constexpr int RS = 2064;
    LAS unsigned char* Th = F.lds; LAS unsigned char* Tl = F.lds + 32 * RS;
    LAS float* lg = (LAS float*)(F.lds + LDS_X + F.wave * 2112);
    LAS unsigned* lcnt = (LAS unsigned*)(F.lds + LDS_CNT); LAS unsigned* lbase = lcnt + 32;
    const bf16_t* wh = (const bf16_t*)(F.ws + WS_WRH); const bf16_t* wl = (const bf16_t*)(F.ws + WS_WRL);
    for (int i = F.tid; i < 32 * 128; i += NTHREADS) { const int e = i >> 7, c = i & 127; *(LAS u32x4*)(Th + e * RS + c * 16) = *(const u32x4*)(wh + e * D + c * 8); *(LAS u32x4*)(Tl + e * RS + c * 16) = *(const u32x4*)(wl + e * D + c * 8); }
    const int lane = F.lane, g = lane >> 4, l15 = lane & 15;
    unsigned* rowtok = (unsigned*)(F.ws + WS_ROWTOK); unsigned* tokpos = (unsigned*)(F.ws + WS_TOKPOS); float* tokgate = (float*)(F.ws + WS_TOKGATE); float* rstd2 = (float*)(F.ws + WS_RSTD2);
    for (int ch = F.bx; ch < M / 128; ch += F.G) {
        if (F.tid < 32) lcnt[F.tid] = 0u;
        __syncthreads();
        const int t0 = ch * 128 + F.wave * 16;
        f32x4 a0 = {0.f, 0.f, 0.f, 0.f}, a1 = {0.f, 0.f, 0.f, 0.f}; float ssq = 0.f;
        const bf16_t* xp = (const bf16_t*)(F.ws + WS_X1) + (size_t)(t0 + l15) * D + 8 * g;
#pragma unroll 8
        for (int s = 0; s < 32; ++s) {
            const u32x4 xw = *(const u32x4*)(xp + 32 * s); f32x4 v0, v1; pg8::unpack8(xw, v0, v1);
            ssq += (v0[0] * v0[0] + v0[1] * v0[1]) + (v0[2] * v0[2] + v0[3] * v0[3]) + (v1[0] * v1[0] + v1[1] * v1[1]) + (v1[2] * v1[2] + v1[3] * v1[3]);
            const bf16x8 xh = __builtin_bit_cast(bf16x8, xw);
            const int ko = (32 * s + 8 * g) * 2;
            const bf16x8 bh0 = *(const LAS bf16x8*)(Th + l15 * RS + ko), bh1 = *(const LAS bf16x8*)(Th + (16 + l15) * RS + ko), bl0 = *(const LAS bf16x8*)(Tl + l15 * RS + ko), bl1 = *(const LAS bf16x8*)(Tl + (16 + l15) * RS + ko);
            a0 = __builtin_amdgcn_mfma_f32_16x16x32_bf16(xh, bh0, a0, 0, 0, 0); a0 = __builtin_amdgcn_mfma_f32_16x16x32_bf16(xh, bl0, a0, 0, 0, 0);
            a1 = __builtin_amdgcn_mfma_f32_16x16x32_bf16(xh, bh1, a1, 0, 0, 0); a1 = __builtin_amdgcn_mfma_f32_16x16x32_bf16(xh, bl1, a1, 0, 0, 0);
        }
        ssq += __shfl_xor(ssq, 16); ssq += __shfl_xor(ssq, 32);
        const float rstd = 1.0f / sqrtf(ssq * (1.f / D) + NORM_EPS);
        { unsigned char* x8 = F.ws + WS_XB + (size_t)(t0 + l15) * D + 8 * g;
#pragma unroll 1
          for (int s0 = 0; s0 < 32; s0 += 16) { u32x4 xw[16];
#pragma unroll
              for (int j = 0; j < 16; ++j) xw[j] = *(const u32x4*)(xp + 32 * (s0 + j));
#pragma unroll
              for (int j = 0; j < 16; ++j) { f32x4 v0, v1; pg8::unpack8(xw[j], v0, v1); *(u32x2*)(x8 + 32 * (s0 + j)) = pg8::pack8_fp8(v0 * rstd, v1 * rstd); } } }
        const float br0 = F.b_router[l15], br1 = F.b_router[16 + l15];
#pragma unroll
        for (int r = 0; r < 4; ++r) { const float rsr = __shfl(rstd, 4 * g + r); lg[(4 * g + r) * 33 + l15] = a0[r] * rsr + br0; lg[(4 * g + r) * 33 + 16 + l15] = a1[r] * rsr + br1; }
        LDS_WAIT(); asm volatile("" ::: "memory");
        int sel_e[4] = {0, 0, 0, 0}; float sel_g[4] = {0.f, 0.f, 0.f, 0.f}; unsigned lpos[4] = {0u, 0u, 0u, 0u};
        if (lane < 16) {
            float v[32];
#pragma unroll
            for (int e = 0; e < 32; ++e) v[e] = lg[lane * 33 + e];
            float tv[4];
#pragma unroll
            for (int k = 0; k < 4; ++k) { float best = -3.0e38f; int bi = 0;
#pragma unroll
                for (int e = 0; e < 32; ++e) { if (v[e] > best) { best = v[e]; bi = e; } }
#pragma unroll
                for (int e = 0; e < 32; ++e) { if (e == bi) v[e] = -3.0e38f; }
                tv[k] = best; sel_e[k] = bi; }
            float den = 0.f;
#pragma unroll
            for (int k = 0; k < 4; ++k) { sel_g[k] = __builtin_amdgcn_exp2f((tv[k] - tv[0]) * LOG2E); den += sel_g[k]; }
            const float idn = 1.0f / den;
#pragma unroll
            for (int k = 0; k < 4; ++k) { sel_g[k] *= idn; lpos[k] = __hip_atomic_fetch_add(lcnt + sel_e[k], 1u, __ATOMIC_RELAXED, __HIP_MEMORY_SCOPE_WORKGROUP); }
            rstd2[t0 + lane] = rstd;
        }
        __syncthreads();
        if (F.tid < 32) lbase[F.tid] = __hip_atomic_fetch_add(F.ctl + CW_CNT + 64 * F.tid, lcnt[F.tid], RLX_AGENT);
        __syncthreads();
        if (lane < 16) { const int tok = t0 + lane;
#pragma unroll
            for (int k = 0; k < 4; ++k) { const unsigned pos = lbase[sel_e[k]] + lpos[k]; rowtok[(size_t)sel_e[k] * CAP + pos] = (unsigned)tok; tokpos[tok * 4 + k] = ((unsigned)sel_e[k] << 20) | pos; tokgate[tok * 4 + k] = sel_g[k]; } }
        __syncthreads();
    }
}
__device__ __forceinline__ void moe_tables(Frame& F, LAS int* tab) {
    if (F.tid == 0) { int ts = 0, rs = 0;
        for (int e = 0; e < NE; ++e) { const int c = (int)__hip_atomic_load(F.ctl + CW_CNT + 64 * e, RLX_AGENT); tab[e] = ts; tab[40 + e] = c; tab[80 + e] = rs; ts += (c + 255) >> 8; rs += c; }
        tab[32] = ts; tab[112] = rs; }
    __syncthreads();
}
__device__ __forceinline__ void p8_combine(Frame& F, const LAS int* tab) {
    const u32x4* tokpos = (const u32x4*)(F.ws + WS_TOKPOS); const f32x4* tokgate = (const f32x4*)(F.ws + WS_TOKGATE);
    const unsigned char* Y = F.ws + WS_Y; const bf16_t* X1 = (const bf16_t*)(F.ws + WS_X1);
    const int gw = F.bx * NWAVES + F.wave, NGW = F.G * NWAVES, lane = F.lane;
    int t = gw; if (t >= M) return;
    u32x4 tp = tokpos[t]; f32x4 tg = tokgate[t];
    for (; t < M; t += NGW) {
        const int tn = (t + NGW < M) ? t + NGW : t;
        const u32x4 tpn = tokpos[tn]; const f32x4 tgn = tokgate[tn];
        u32x4 yw[4];
#pragma unroll
        for (int k = 0; k < 4; ++k) { const int e = tp[k] >> 20, pos = tp[k] & 0xfffff; const int row = tab[80 + e] + pos; yw[k] = LD_P8((const u32x4*)(Y + (size_t)row * D + 16 * lane)); }
        const u32x4 xa = LD_P8((const u32x4*)(X1 + (size_t)t * D + 16 * lane)), xb = LD_P8((const u32x4*)(X1 + (size_t)t * D + 16 * lane + 8));
        f32x4 o[4]; pg8::unpack8(xa, o[0], o[1]); pg8::unpack8(xb, o[2], o[3]);
#pragma unroll
        for (int k = 0; k < 4; ++k) { const float gk = tg[k];
#pragma unroll
            for (int q = 0; q < 4; ++q) { const f32x2 lo = __builtin_amdgcn_cvt_pk_f32_fp8((int)yw[k][q], false), hi = __builtin_amdgcn_cvt_pk_f32_fp8((int)yw[k][q], true);
                o[q][0] += gk * lo[0]; o[q][1] += gk * lo[1]; o[q][2] += gk * hi[0]; o[q][3] += gk * hi[1]; } }
        float* op = F.out + (size_t)t * D + 16 * lane;
#pragma unroll
        for (int q = 0; q < 4; ++q) ST_P8(o[q], (f32x4*)(op + 4 * q));
        tp = tpn; tg = tgn;
    }
}

#ifndef SLACK_US
#define SLACK_US 0
#endif
__device__ __forceinline__ void slack_delay(int nunits, int G, int c) {
    const int nmax = (nunits + G - 1) / G, mine = (nunits > c) ? (nunits - c + G - 1) / G : 0;
    if (mine < nmax && SLACK_US > 0) { const unsigned long long t0 = __builtin_amdgcn_s_memrealtime(); while (__builtin_amdgcn_s_memrealtime() - t0 < (unsigned long long)(SLACK_US * 100)) __builtin_amdgcn_s_sleep(16); }
}
constexpr int N_PHASES = 9;
#ifndef XPRE
#define XPRE 4
#endif
__global__ void __launch_bounds__(NTHREADS, 2) mk_fwd(Args args) {
    extern __shared__ __attribute__((aligned(16))) unsigned char lds_raw[];
    Frame F;
    F.lds = (LAS unsigned char*)lds_raw; F.MISC = (volatile LAS unsigned*)(F.lds + LDS_MISC);
    F.tid = threadIdx.x; F.lane = F.tid & 63; F.wave = __builtin_amdgcn_readfirstlane(F.tid >> 6); F.G = gridDim.x; F.bx = blockIdx.x;
    F.ws = args.ws; F.ctl = (unsigned*)(args.ws + WS_CTL); F.out = args.out;
    F.x = args.in[0]; F.norm_mix = args.in[1]; F.w_in = args.in[2]; F.conv_w = args.in[3]; F.w_out_conv = args.in[4]; F.q_norm = args.in[5]; F.k_norm = args.in[6]; F.rpb = args.in[7];
    F.w_out_attn = args.in[8]; F.w_o = args.in[9]; F.norm_ffn = args.in[10]; F.w_router = args.in[11]; F.b_router = args.in[12]; F.w_gate = args.in[13]; F.b_gate = args.in[14];
    F.w_up = args.in[15]; F.b_up = args.in[16]; F.w_down = args.in[17]; F.b_down = args.in[18];
    if (F.tid < 64) F.MISC[F.tid] = 0u;
    __syncthreads();
    XcdBarrier bar; bar.bar = F.ctl + CW_BAR; bar.x = 0; bar.st = nullptr;
#if !MK_MULTI
    bar = xcd_barrier_post(F.ctl + CW_BAR, F.MISC + 8);
#define GRID_BAR() do { SW_BEGIN(16) xcd_barrier(bar); SW_END(16); } while (0)
#else
#define GRID_BAR() do {} while (0)
#endif
    const int lo = args.ph_lo, hi = args.ph_hi;
#define IN(k) (lo <= (k) && (k) < hi)
#define SEAM(k) do { if (IN(k) && IN((k) + 1)) { SW_BEGIN(40) GRID_BAR(); SW_END_ID(40, 40 + (k)); } } while (0)
#ifndef PROBE_NOEPI
#define PROBE_NOEPI 0
#endif
#define NOEPI_ON(k) ((PROBE_NOEPI >> (k)) & 1)
#define REPS(k) (1 + ((PROBE_REP >> (k)) & 1))
#define REP_BEGIN(k) _Pragma("unroll") for (int rep_##k = 0; rep_##k < REPS(k); ++rep_##k) { if (rep_##k > 0) GRID_BAR();
#define REP_END }
    bf16_t* Hb = (bf16_t*)F.out; bf16_t* za = (bf16_t*)F.out + (size_t)M * D;
    LAS int* tab = (LAS int*)(F.lds + LDS_TAB);

    if (IN(0)) { SW_BEGIN(1) REP_BEGIN(0) p0_prologue(F); REP_END SEAM(0); SW_END(1); }
#if PROBE_SW == 19
    { xcd_barrier(bar); SW_BEGIN(19) xcd_barrier(bar); xcd_barrier(bar); xcd_barrier(bar); xcd_barrier(bar); SW_END(19); }
#endif
    if (IN(1)) {
        SW_BEGIN(2)
        pg8::DenseOrder S; S.init(Hb, F.ws + WS_WIN, M, PROJW, D * 2, F.G, F.bx);
        pg8::EpiInProj E{(bf16_t*)(F.ws + WS_U), (bf16_t*)(F.ws + WS_BG), (bf16_t*)(F.ws + WS_Q), (bf16_t*)(F.ws + WS_K), (bf16_t*)(F.ws + WS_V), (bf16_t*)(F.ws + WS_R), (bf16_t*)(F.ws + WS_SB), F.q_norm, F.k_norm};
        const int npre = ((F.bx >> 3) & 3) * XPRE;
        { SW_BEGIN(10) p0_expert_items(F, 0, npre); __syncthreads(); SW_END(10); }
        if constexpr (NOEPI_ON(1)) { pg8::gemm_phase<pg8::EpiInProj, pg8::DenseOrder, false, true, false, true>(F.lds, D * 2, S, E); GRID_BAR(); }
        REP_BEGIN(1) pg8::gemm_phase<pg8::EpiInProj, pg8::DenseOrder, false, true, false>(F.lds, D * 2, S, E); REP_END
        { SW_BEGIN(10) p0_expert_items(F, npre, XITEMS_PER_WAVE); SW_END(10); }
        SEAM(1);
        SW_END(2);
    }
    if (IN(2)) { SW_BEGIN(3) REP_BEGIN(2) REP_BEGIN(9) { SW_BEGIN(17) p2_conv(F); SW_END(17); } REP_END { const int nrep_ = ((PROBE_REP >> 10) & 1) ? (hi > 100 ? 1 : 2) : 1; _Pragma("unroll 1") for (int r_ = 0; r_ < nrep_; ++r_) { if (r_ > 0) GRID_BAR(); p2_attn(F, za); } } REP_END SEAM(2); SW_END(3); }
    if (IN(3)) {
        SW_BEGIN(4)
        pg8::DenseOrder S; S.init(za, F.ws + WS_WCA, M, D, D * 2, F.G, F.bx);
        pg8::EpiMix E{(const bf16_t*)(F.ws + WS_R), (const bf16_t*)(F.ws + WS_SB), (bf16_t*)(F.ws + WS_MIXED)};
#ifndef PROBE_P3
#define PROBE_P3 0
#endif
        if constexpr (PROBE_P3 == 1) { pg8::gemm_phase<pg8::EpiMix, pg8::DenseOrder, false, true, false, true, true>(F.lds, D * 2, S, E); GRID_BAR(); }
        if constexpr (PROBE_P3 == 2) { pg8::gemm_phase<pg8::EpiMix, pg8::DenseOrder, false, true, false, true, false>(F.lds, D * 2, S, E); GRID_BAR(); }
        REP_BEGIN(3) pg8::gemm_phase<pg8::EpiMix, pg8::DenseOrder, false, true, false>(F.lds, D * 2, S, E); REP_END
        SEAM(3);
        SW_END(4);
    }
    if (IN(4)) {
        SW_BEGIN(5)
        pg8::DenseOrder S; S.init(F.ws + WS_MIXED, F.ws + WS_WO, M, D, D * 2, F.G, F.bx);
        pg8::EpiResid E{F.x, (bf16_t*)(F.ws + WS_X1)};
        REP_BEGIN(4) pg8::gemm_phase<pg8::EpiResid, pg8::DenseOrder, false, true, false>(F.lds, D * 2, S, E); REP_END
        SEAM(4);
        SW_END(5);
    }
    if (IN(5)) {
        if constexpr ((PROBE_REP >> 5) & 1) { p5_router(F); GRID_BAR(); if (F.bx == 0 && F.tid < NE) __hip_atomic_store(F.ctl + CW_CNT + 64 * F.tid, 0u, RLX_AGENT); GRID_BAR(); }
        { SW_BEGIN(6) p5_router(F); SEAM(5); SW_END(6); } }
    if (IN(6)) {
        SW_BEGIN(7)
        moe_tables(F, tab);
        const int ntiles = tab[32];
        pg8::MoeOrder S; S.init(F.ws + WS_XB, F.ws + WS_WGU, (const unsigned*)(F.ws + WS_ROWTOK), tab, 0, ntiles, 2 * FF, D, F.G, F.bx, true);
        pg8::EpiSwiglu E{F.b_gate, F.b_up, F.ws + WS_ACT};
        slack_delay(ntiles * 8, F.G, F.bx);
        if constexpr (NOEPI_ON(6)) { pg8::gemm_phase<pg8::EpiSwiglu, pg8::MoeOrder, true, true, true, true>(F.lds, D, S, E); GRID_BAR(); }
        REP_BEGIN(6) pg8::gemm_phase<pg8::EpiSwiglu, pg8::MoeOrder, true, true, true>(F.lds, D, S, E); REP_END
        SEAM(6);
        SW_END(7);
    }
    if (IN(7) || IN(8)) {
        moe_tables(F, tab);
        const int ntiles = tab[32];
        if (IN(7)) {
            SW_BEGIN(8)
            pg8::EpiDown E{F.b_down, F.ws + WS_Y};
            pg8::MoeOrder S; S.init(F.ws + WS_ACT, F.ws + WS_WD, nullptr, tab, 0, ntiles, D, FF, F.G, F.bx, false);
            slack_delay(ntiles * 4, F.G, F.bx);
            if constexpr (NOEPI_ON(7)) { pg8::gemm_phase<pg8::EpiDown, pg8::MoeOrder, false, true, true, true>(F.lds, FF, S, E); GRID_BAR(); }
            REP_BEGIN(7) pg8::gemm_phase<pg8::EpiDown, pg8::MoeOrder, false, true, true>(F.lds, FF, S, E); REP_END
            SEAM(7);
            SW_END(8);
        }
        if (IN(8)) { SW_BEGIN(9) REP_BEGIN(8) p8_combine(F, tab); REP_END SW_END(9); }
    }
#if PROBE_SW
    if (F.bx == SW_BLOCK && F.tid == 0) { const unsigned long long tot = *(volatile LAS unsigned long long*)(size_t)(SW_LDS_OFF) * (unsigned long long)SW_MULT; const unsigned long long t0 = __builtin_amdgcn_s_memrealtime();
        while (__builtin_amdgcn_s_memrealtime() - t0 < tot) __builtin_amdgcn_s_sleep(8); }
#endif
}

extern "C" void kernel_launch(void* const* d_in, const int* in_sizes, int n_in, void* d_out, int out_size, void* d_ws, size_t ws_size, hipStream_t stream) {
    static int grid = 0;
    if (grid == 0) {
        if (n_in != 19 || out_size != M * D || ws_size < WS_END) { fprintf(stderr, "kernel_launch: unexpected shapes / workspace (%zu < %zu)\n", ws_size, (size_t)WS_END); grid = -1; return; }
        if (hipFuncSetAttribute((const void*)mk_fwd, hipFuncAttributeMaxDynamicSharedMemorySize, LDS_BYTES) != hipSuccess) { fprintf(stderr, "kernel_launch: hipFuncSetAttribute failed\n"); grid = -1; return; }
        int dev = 0, cus = 0, per_cu = 0;
        (void)hipGetDevice(&dev); (void)hipDeviceGetAttribute(&cus, hipDeviceAttributeMultiprocessorCount, dev);
        (void)hipOccupancyMaxActiveBlocksPerMultiprocessor(&per_cu, (const void*)mk_fwd, NTHREADS, LDS_BYTES);
        (void)hipGetLastError();
        grid = cus > 0 ? cus : 256;
    }
    if (grid < 0) return;
    (void)hipMemsetAsync((char*)d_ws + WS_CTL, 0, CTL_ZERO_BYTES, stream);
    Args a{};
    for (int i = 0; i < 19; ++i) a.in[i] = (const float*)d_in[i];
    a.out = (float*)d_out; a.ws = (unsigned char*)d_ws;
#if MK_MULTI
    for (int p = 0; p < N_PHASES; ++p) { a.ph_lo = p; a.ph_hi = p + 1; hipLaunchKernelGGL(mk_fwd, dim3(grid), dim3(NTHREADS), LDS_BYTES, stream, a); }
#else
    a.ph_lo = 0; a.ph_hi = N_PHASES;
    hipLaunchKernelGGL(mk_fwd, dim3(grid), dim3(NTHREADS), LDS_BYTES, stream, a);
#endif
}
```
